# Optimizing an MI355X kernel written in HIP

```python
import math
import jax, jax.numpy as jnp
from jax import lax
import numpy as np

D_MODEL = 4096
BATCH = 4
SEQ = 4096
DEPTH = 2
DEC_BATCH = 8
DEC_SEQ = 2048
PAST_LEN = 128

N_MIXERS = 2
N_HEADS = 16
HEAD_DIM = 128
V_DIM = 2 * HEAD_DIM
ROT_DIM = HEAD_DIM // 4
ROPE_THETA = 500000.0
Q_BLOCK = 128
N_FOURIER_GROUPS = 8
FOURIER_GROUP_DIM = D_MODEL // N_FOURIER_GROUPS
D_FF = ((8 * D_MODEL // 3 + 255) // 256) * 256
N_ATTN_LAYERS = (DEPTH + N_MIXERS - 1) // N_MIXERS
N_FOURIER_LAYERS = DEPTH // N_MIXERS
EPS = 1e-6
SUBLN_EPS = 1e-5
LAMBDA_STD = 0.1

kernel_name = "hybrid_diffattn_fnet_encoder"


def rmsnorm(x, g, eps=EPS):
    xf = x.astype(jnp.float32)
    y = xf * lax.rsqrt(jnp.mean(xf * xf, axis=-1, keepdims=True) + eps) * g.astype(jnp.float32)
    return y.astype(x.dtype)


def rope_tables(seq_len):
    inv_freq = ROPE_THETA ** (-jnp.arange(0, ROT_DIM, 2, dtype=jnp.float32) / ROT_DIM)
    ang = jnp.arange(seq_len, dtype=jnp.float32)[:, None] * inv_freq[None, :]
    return jnp.cos(ang)[:, None, None, :], jnp.sin(ang)[:, None, None, :]


def apply_partial_rope(t, cos, sin):
    rot = t[..., :ROT_DIM].astype(jnp.float32)
    t1, t2 = rot[..., :ROT_DIM // 2], rot[..., ROT_DIM // 2:]
    r = jnp.concatenate([t1 * cos - t2 * sin, t2 * cos + t1 * sin], axis=-1)
    return jnp.concatenate([r.astype(t.dtype), t[..., ROT_DIM:]], axis=-1)


def diff_attention(h, w_qkv, w_o, lq1, lk1, lq2, lk2, subln, lambda_init):
    B, S, _ = h.shape
    qkv = h @ w_qkv
    q, k, v = jnp.split(qkv, 3, axis=-1)
    q = q.reshape(B, S, N_HEADS, 2, HEAD_DIM)
    k = k.reshape(B, S, N_HEADS, 2, HEAD_DIM)
    v = v.reshape(B, S, N_HEADS, V_DIM)
    cos, sin = rope_tables(S)
    q = apply_partial_rope(q, cos, sin) * (HEAD_DIM ** -0.5)
    k = apply_partial_rope(k, cos, sin)
    lam = (jnp.exp(jnp.sum(lq1.astype(jnp.float32) * lk1.astype(jnp.float32)))
           - jnp.exp(jnp.sum(lq2.astype(jnp.float32) * lk2.astype(jnp.float32)))
           + lambda_init)
    n_blk = S // Q_BLOCK
    q_blocks = q.reshape(B, n_blk, Q_BLOCK, N_HEADS, 2, HEAD_DIM).transpose(1, 0, 2, 3, 4, 5)

    def attend(qb):
        s = jnp.einsum('bqhcd,bkhcd->bhcqk', qb, k, preferred_element_type=jnp.float32)
        p = jax.nn.softmax(s, axis=-1)
        a = p[:, :, 0] - lam * p[:, :, 1]
        return jnp.einsum('bhqk,bkhe->bqhe', a.astype(v.dtype), v)

    o = lax.map(attend, q_blocks)
    o = o.transpose(1, 0, 2, 3, 4).reshape(B, S, N_HEADS, V_DIM)
    o = rmsnorm(o, subln, SUBLN_EPS) * (1.0 - lambda_init)
    return o.reshape(B, S, D_MODEL) @ w_o


def fourier_mix(h, w_f):
    B, S, _ = h.shape
    hg = h.astype(jnp.float32).reshape(B, S, N_FOURIER_GROUPS, FOURIER_GROUP_DIM)
    f = jnp.fft.fft2(hg, axes=(1, 3), norm='ortho').real
    return f.astype(h.dtype).reshape(B, S, D_MODEL) @ w_f


def swiglu(h, w_gate_up, w_down):
    g, u = jnp.split(h @ w_gate_up, 2, axis=-1)
    return (jax.nn.silu(g) * u) @ w_down


def trunk(x, norm_mix, norm_ffn, norm_final, attn_w_qkv, attn_w_o, attn_lambda_q1, attn_lambda_k1,
          attn_lambda_q2, attn_lambda_k2, attn_subln, fourier_w_o, ffn_w_gate_up, ffn_w_down):
    for i in range(DEPTH):
        h = rmsnorm(x, norm_mix[i])
        j = i // N_MIXERS
        if i % N_MIXERS == 0:
            lambda_init = 0.8 - 0.6 * math.exp(-0.3 * i)
            x = x + diff_attention(h, attn_w_qkv[j], attn_w_o[j], attn_lambda_q1[j], attn_lambda_k1[j],
                                   attn_lambda_q2[j], attn_lambda_k2[j], attn_subln[j], lambda_init)
        else:
            x = x + fourier_mix(h, fourier_w_o[j])
        x = x + swiglu(rmsnorm(x, norm_ffn[i]), ffn_w_gate_up[i], ffn_w_down[i])
    return rmsnorm(x, norm_final)


def setup_inputs(seed: int = 0) -> dict:
    key = jax.random.key(seed)
    ks = jax.random.split(key, 16)
    f32 = jnp.float32
    d_sc = D_MODEL ** -0.5
    return {
        'x_prompt': jax.random.normal(ks[0], (BATCH, SEQ, D_MODEL), f32),
        'x_sample': jax.random.normal(ks[1], (DEC_BATCH, DEC_SEQ, D_MODEL), f32),
        'norm_mix': 1.0 + 0.02 * jax.random.normal(ks[2], (DEPTH, D_MODEL), f32),
        'norm_ffn': 1.0 + 0.02 * jax.random.normal(ks[3], (DEPTH, D_MODEL), f32),
        'norm_final': 1.0 + 0.02 * jax.random.normal(ks[4], (D_MODEL,), f32),
        'attn_w_qkv': jax.random.normal(ks[5], (N_ATTN_LAYERS, D_MODEL, 3 * D_MODEL), f32) * d_sc,
        'attn_w_o': jax.random.normal(ks[6], (N_ATTN_LAYERS, D_MODEL, D_MODEL), f32) * d_sc,
        'attn_lambda_q1': LAMBDA_STD * jax.random.normal(ks[7], (N_ATTN_LAYERS, HEAD_DIM), f32),
        'attn_lambda_k1': LAMBDA_STD * jax.random.normal(ks[8], (N_ATTN_LAYERS, HEAD_DIM), f32),
        'attn_lambda_q2': LAMBDA_STD * jax.random.normal(ks[9], (N_ATTN_LAYERS, HEAD_DIM), f32),
        'attn_lambda_k2': LAMBDA_STD * jax.random.normal(ks[10], (N_ATTN_LAYERS, HEAD_DIM), f32),
        'attn_subln': 1.0 + 0.02 * jax.random.normal(ks[11], (N_ATTN_LAYERS, V_DIM), f32),
        'fourier_w_o': jax.random.normal(ks[12], (N_FOURIER_LAYERS, D_MODEL, D_MODEL), f32) * d_sc,
        'ffn_w_gate_up': jax.random.normal(ks[13], (DEPTH, D_MODEL, 2 * D_FF), f32) * d_sc,
        'ffn_w_down': jax.random.normal(ks[14], (DEPTH, D_FF, D_MODEL), f32) * (D_FF ** -0.5),
    }


def reference(x_prompt, x_sample, norm_mix, norm_ffn, norm_final, attn_w_qkv, attn_w_o, attn_lambda_q1,
              attn_lambda_k1, attn_lambda_q2, attn_lambda_k2, attn_subln, fourier_w_o, ffn_w_gate_up, ffn_w_down):
    y_prompt = trunk(x_prompt, norm_mix, norm_ffn, norm_final, attn_w_qkv, attn_w_o, attn_lambda_q1,
                     attn_lambda_k1, attn_lambda_q2, attn_lambda_k2, attn_subln, fourier_w_o,
                     ffn_w_gate_up, ffn_w_down)
    y_sample = trunk(x_sample, norm_mix, norm_ffn, norm_final, attn_w_qkv, attn_w_o, attn_lambda_q1,
                     attn_lambda_k1, attn_lambda_q2, attn_lambda_k2, attn_subln, fourier_w_o,
                     ffn_w_gate_up, ffn_w_down)
    return (y_prompt, y_sample)
```

```cpp
#include <hip/hip_runtime.h>
#include <cstdio>
#include <cstdint>

#ifndef MK_PER_PHASE
#define MK_PER_PHASE 0
#endif

constexpr int DM = 4096, NTOK = 32768, NTOK_P = 16384, SEQ_P = 4096, SEQ_S = 2048, NB_P = 4, NB_S = 8;
constexpr int DFF = 11008, NQKV = 3 * DM, NGU = 2 * DFF;
constexpr int NH = 16, HD = 128, VD = 256, NGRP = 8, GDIM = 512;
constexpr float RMS_EPS = 1e-6f, SUBLN_EPS = 1e-5f, LAMBDA_INIT = 0.2f;
constexpr int N_PHASES = 15;
constexpr float QK_LOG2_SCALE = 0.088388347648318440f * 1.4426950408889634f;
#ifndef PG8_SP2
#define PG8_SP2 true
#endif
#ifndef WGM_DOWN
#define WGM_DOWN 2
#endif
#ifndef PG8_ALIGN
#define PG8_ALIGN true
#endif

constexpr size_t MiB = 1u << 20;
constexpr size_t WS_CTL = 0, CTL_ZERO_BYTES = 64 * 1024;
constexpr size_t WS_SS = 1 * MiB;
constexpr size_t WS_ROPE = 3 * MiB;
constexpr size_t WS_AVEC = 7 * MiB / 2;
constexpr size_t WS_WC = 4 * MiB;
constexpr size_t WS_D4096 = 12 * MiB;
constexpr size_t WS_D2048 = 76 * MiB;
constexpr size_t WS_WQKV = 92 * MiB, WS_WO = 188 * MiB, WS_WF = 220 * MiB, WS_WGU0 = 252 * MiB, WS_WGU1 = 424 * MiB, WS_WD0 = 596 * MiB, WS_WD1 = 682 * MiB;
constexpr size_t WS_XB = 768 * MiB;
constexpr size_t WS_QKV = 1024 * MiB;
constexpr size_t WS_HB = WS_QKV;
constexpr size_t WS_OB = 1792 * MiB;
constexpr size_t WS_YT = WS_OB;
constexpr size_t WS_OC = 2304 * MiB;
constexpr size_t WS_F = WS_OC;
constexpr size_t WS_XF = WS_OC;
constexpr size_t WS_END = 2560 * MiB;
constexpr int CW_BAR = 4096;

#define GAS __attribute__((address_space(1)))
#define LAS __attribute__((address_space(3)))
typedef unsigned short bf16;
typedef unsigned v4u __attribute__((ext_vector_type(4)));
typedef unsigned v2u __attribute__((ext_vector_type(2)));
typedef float f32x4 __attribute__((ext_vector_type(4)));
typedef short bf16x8 __attribute__((ext_vector_type(8)));
typedef GAS unsigned gu32;
#define RLX_AGENT __ATOMIC_RELAXED, __HIP_MEMORY_SCOPE_AGENT
#define LDS_WAIT() asm volatile("s_waitcnt lgkmcnt(0)" ::: "memory")
#define VM_WAIT() asm volatile("s_waitcnt vmcnt(0)" ::: "memory")

__device__ __forceinline__ unsigned cvt_pk_bf16(float lo, float hi) { unsigned r; asm volatile("v_cvt_pk_bf16_f32 %0, %1, %2" : "=v"(r) : "v"(lo), "v"(hi)); return r; }
__device__ __forceinline__ float bf_lo(unsigned w) { return __uint_as_float(w << 16); }
__device__ __forceinline__ float bf_hi(unsigned w) { return __uint_as_float(w & 0xffff0000u); }
typedef unsigned long long u64;
constexpr float SS_SCALE = 16777216.f;
__device__ __forceinline__ u64 ss_fix(float s) { return (u64)(s * SS_SCALE); }
__device__ __forceinline__ float ss_rstd(u64 q) { return rsqrtf((float)q * (1.f / (SS_SCALE * DM)) + RMS_EPS); }
__device__ __forceinline__ float wave_sum(float v) {
#pragma unroll
    for (int o = 1; o < 64; o <<= 1) v += __shfl_xor(v, o);
    return v;
}

namespace pg8 {
#define PG8_LAS __attribute__((address_space(3)))
typedef unsigned short bf16_t;
typedef unsigned u32x4 __attribute__((ext_vector_type(4)));
constexpr int BM = 256, BK = 64, HALF = 128, HTB = HALF * BK * 2, STAGE_BYTES = 8 * HTB, NXCD = 8, WGM = 8;

__host__ __device__ __forceinline__ int lds_byte(int r, int c) { const int st = (r >> 4) * 2 + (c >> 5), rr = r & 15, cc = c & 31, ob = rr * 64 + cc * 2; return st * 1024 + (ob ^ (((ob >> 9) & 1) << 5)); }
__host__ __device__ __forceinline__ void stage_rc(int b, int& R, int& C) { const int st = b / 1024, sb = b % 1024, swz = sb ^ (((sb >> 9) & 1) << 5); R = (st >> 1) * 16 + swz / 64; C = (st & 1) * 32 + (swz % 64) / 2; }
__host__ __device__ __forceinline__ int perm32(int rho) { const int n = rho >> 4, i = rho & 15; return 8 * (i >> 2) + 4 * n + (i & 3); }

struct Unit { int pm, pn; };

struct StaticOrder {
    int nM, nN, nwg, G, c, wgm;
    __host__ __device__ void init(int nM_, int nN_, int G_, int c_, int wgm_ = WGM) { nM = nM_; nN = nN_; nwg = nM * nN; G = G_; c = c_; wgm = wgm_; }
    __host__ __device__ bool next(int i, Unit& u) const {
        const long L = (long)i * G + c; if (L >= nwg) return false;
        int wgid = (int)L; { const int q = nwg / NXCD, r = nwg % NXCD, xcd = wgid % NXCD, off = wgid / NXCD; wgid = (xcd < r ? xcd * (q + 1) : r * (q + 1) + (xcd - r) * q) + off; }
        const int nig = wgm * nN, gid = wgid / nig, fm = gid * wgm, gsz = (nM - fm) < wgm ? (nM - fm) : wgm;
        u.pm = fm + ((wgid % nig) % gsz); u.pn = (wgid % nig) / gsz; return true;
    }
};

template <class Prob, class Epi, class Sched, bool ALIGN_EPI, bool SP2>
__device__ __forceinline__ void gemm_phase(PG8_LAS unsigned char* lds, const Prob& P, const Sched& S, const Epi& E) {
    const int tid = threadIdx.x, wid = __builtin_amdgcn_readfirstlane(tid >> 6), lane = tid & 63, wr = wid >> 2, wc = wid & 3, fr = lane & 15, fq = lane >> 4;
    const int K = P.K, nt = K / BK, lda = P.lda, ldb = P.ldb;
    unsigned voffA[2], voffB[2];
#pragma unroll
    for (int i = 0; i < 2; ++i) { int R, C; stage_rc(tid * 16 + i * 8192, R, C); const int Rb = Epi::PERM ? ((R & ~31) + perm32(R & 31)) : R;
        voffA[i] = (unsigned)(R * lda + C) * 2u; voffB[i] = (unsigned)(Rb * ldb + C) * 2u; }
    const size_t kstep = (size_t)(BK * 2);
    const size_t Kb = (size_t)nt * kstep, rotb = (size_t)((((int)blockIdx.x & 7) * (nt >> 3)) & ~1) * kstep;
#define PG8_KOFF(t) ({ size_t x_ = (size_t)(t) * kstep + rotb; x_ >= Kb ? x_ - Kb : x_; })
    const size_t hA = (size_t)HALF * lda * 2, hB = (size_t)HALF * ldb * 2;
    const unsigned ldsw = (unsigned)wid * 1024u;
    const unsigned ldsb = (unsigned)(uintptr_t)lds + ldsw;
    const int aoff = lds_byte(wr * 64 + fr, fq * 8), boff = lds_byte(wc * 32 + fr, fq * 8);
#define PG8_SA(b, h) (((b) * 2 + (h)) * HTB)
#define PG8_SB(b, h) ((4 + (b) * 2 + (h)) * HTB)
#define PG8_STAGE(bufoff, gbase, voff) do { _Pragma("unroll") for (int _i = 0; _i < 2; ++_i) \
        asm volatile("s_mov_b32 m0, %2\n\ts_nop 0\n\tglobal_load_lds_dwordx4 %0, %1" :: "v"((voff)[_i]), "s"((const char*)(gbase)), "s"(ldsb + (unsigned)((bufoff) + _i * 8192)) : "memory", "m0"); } while (0)
#define PG8_LDA(dst, b, h) do { _Pragma("unroll") for (int m = 0; m < 4; ++m) _Pragma("unroll") for (int k = 0; k < 2; ++k) dst[m][k] = *(const PG8_LAS bf16x8*)(lds + PG8_SA(b, h) + aoff + m * 2048 + k * 1024); } while (0)
#define PG8_LDB(dst, b, h) do { _Pragma("unroll") for (int n = 0; n < 2; ++n) _Pragma("unroll") for (int k = 0; k < 2; ++k) dst[n][k] = *(const PG8_LAS bf16x8*)(lds + PG8_SB(b, h) + boff + n * 2048 + k * 1024); } while (0)
#define PG8_MMA(ai, bj, At, Bt) do { __builtin_amdgcn_s_setprio(1); _Pragma("unroll") for (int m = 0; m < 4; ++m) _Pragma("unroll") for (int n = 0; n < 2; ++n) _Pragma("unroll") for (int k = 0; k < 2; ++k) \
        acc[ai][bj][m][n] = __builtin_amdgcn_mfma_f32_16x16x32_bf16(Bt[n][k], At[m][k], acc[ai][bj][m][n], 0, 0, 0); __builtin_amdgcn_s_setprio(0); } while (0)
#define PG8_WAIT_V(n) asm volatile("s_waitcnt vmcnt(" #n ")" ::: "memory")
#define PG8_WAIT_L(n) asm volatile("s_waitcnt lgkmcnt(" #n ")" ::: "memory")
#define PG8_BAR __builtin_amdgcn_s_barrier()
#define PG8_SCHED __builtin_amdgcn_sched_barrier(0)
    Unit cur, nxt; int ui = 0;
    if (!S.next(0, cur)) return;
    f32x4 acc[2][2][4][2];
#pragma unroll
    for (int a = 0; a < 2; ++a)
#pragma unroll
        for (int b = 0; b < 2; ++b)
#pragma unroll
            for (int m = 0; m < 4; ++m)
#pragma unroll
                for (int n = 0; n < 2; ++n) acc[a][b][m][n] = (f32x4){0.f, 0.f, 0.f, 0.f};
    bf16x8 At[4][2], B0[2][2], B1[2][2];
    const char* cA = P.a_ptr(cur); const char* cB = P.b_ptr(cur);
    if constexpr (SP2) {
        const char* cA0 = cA + rotb; const char* cB0 = cB + rotb;
        PG8_STAGE(PG8_SB(0, 0), cB0, voffB); PG8_STAGE(PG8_SB(0, 1), cB0 + hB, voffB); PG8_STAGE(PG8_SA(0, 0), cA0, voffA); PG8_STAGE(PG8_SA(0, 1), cA0 + hA, voffA);
        if (wr == 1) PG8_BAR;
        PG8_WAIT_V(2); PG8_BAR;
        PG8_STAGE(PG8_SB(1, 0), cB0 + kstep, voffB); PG8_STAGE(PG8_SA(1, 0), cA0 + kstep, voffA); PG8_STAGE(PG8_SB(1, 1), cB0 + hB + kstep, voffB);
        PG8_WAIT_V(6); PG8_BAR;
    } else {
        PG8_STAGE(PG8_SB(0, 0), cB, voffB); PG8_STAGE(PG8_SA(0, 0), cA, voffA); PG8_STAGE(PG8_SB(0, 1), cB + hB, voffB); PG8_STAGE(PG8_SA(0, 1), cA + hA, voffA);
        if (wr == 1) PG8_BAR;
        PG8_WAIT_V(4); PG8_BAR;
        PG8_STAGE(PG8_SB(1, 0), cB + kstep, voffB); PG8_STAGE(PG8_SA(1, 0), cA + kstep, voffA); PG8_STAGE(PG8_SB(1, 1), cB + hB + kstep, voffB);
        PG8_WAIT_V(6); PG8_BAR;
    }
    for (;;) {
        const bool has_next = S.next(ui + 1, nxt);
        const char* nA = has_next ? P.a_ptr(nxt) : cA; const char* nB = has_next ? P.b_ptr(nxt) : cB;
        for (int t = 0; t < nt; t += 2) {
            const bool last = (t == nt - 2);
            const char* a1 = cA + PG8_KOFF(t) + kstep;
            const size_t ko2 = PG8_KOFF(t + 2);
            const char* a2 = last ? nA + rotb : cA + ko2; const char* b2 = last ? nB + rotb : cB + ko2;
            const char* a3 = a2 + kstep; const char* b3 = b2 + kstep;
            if constexpr (SP2) {
            PG8_LDB(B0, 0, 0); PG8_LDB(B1, 0, 1); PG8_SCHED; PG8_LDA(At, 0, 0); PG8_STAGE(PG8_SA(1, 1), a1 + hA, voffA);
            PG8_WAIT_V(8); PG8_WAIT_L(0); PG8_BAR; PG8_MMA(0, 0, At, B0); PG8_MMA(0, 1, At, B1); PG8_BAR; PG8_SCHED;
            PG8_LDA(At, 0, 1); PG8_STAGE(PG8_SB(0, 0), b2, voffB); PG8_STAGE(PG8_SB(0, 1), b2 + hB, voffB); PG8_STAGE(PG8_SA(0, 0), a2, voffA);
            PG8_WAIT_V(8); PG8_WAIT_L(0); PG8_BAR; PG8_MMA(1, 0, At, B0); PG8_MMA(1, 1, At, B1); PG8_BAR; PG8_SCHED;
            PG8_LDB(B0, 1, 0); PG8_LDB(B1, 1, 1); PG8_SCHED; PG8_LDA(At, 1, 0); PG8_STAGE(PG8_SA(0, 1), a2 + hA, voffA);
            PG8_WAIT_V(8); PG8_WAIT_L(0); PG8_BAR; PG8_MMA(0, 0, At, B0); PG8_MMA(0, 1, At, B1); PG8_BAR; PG8_SCHED;
            PG8_LDA(At, 1, 1); PG8_STAGE(PG8_SB(1, 0), b3, voffB); PG8_STAGE(PG8_SB(1, 1), b3 + hB, voffB); PG8_STAGE(PG8_SA(1, 0), a3, voffA);
            PG8_WAIT_V(8); PG8_WAIT_L(0); PG8_BAR; PG8_MMA(1, 0, At, B0); PG8_MMA(1, 1, At, B1); PG8_BAR; PG8_SCHED;
            } else {
            PG8_LDB(B0, 0, 0); PG8_SCHED; PG8_LDA(At, 0, 0); PG8_STAGE(PG8_SA(1, 1), a1 + hA, voffA);
            PG8_WAIT_L(8); PG8_BAR; PG8_WAIT_L(0); PG8_MMA(0, 0, At, B0); PG8_BAR; PG8_SCHED;
            PG8_LDB(B1, 0, 1); PG8_STAGE(PG8_SB(0, 0), b2, voffB);
            PG8_BAR; PG8_WAIT_L(0); PG8_MMA(0, 1, At, B1); PG8_BAR;
            PG8_LDA(At, 0, 1); PG8_STAGE(PG8_SA(0, 0), a2, voffA);
            PG8_BAR; PG8_WAIT_L(0); PG8_MMA(1, 0, At, B0); PG8_BAR; PG8_SCHED;
            PG8_STAGE(PG8_SB(0, 1), b2 + hB, voffB);
            PG8_WAIT_V(6); PG8_BAR; PG8_MMA(1, 1, At, B1); PG8_BAR;
            PG8_LDB(B0, 1, 0); PG8_SCHED; PG8_LDA(At, 1, 0); PG8_STAGE(PG8_SA(0, 1), a2 + hA, voffA);
            PG8_WAIT_L(8); PG8_BAR; PG8_WAIT_L(0); PG8_MMA(0, 0, At, B0); PG8_BAR; PG8_SCHED;
            PG8_LDB(B1, 1, 1); PG8_STAGE(PG8_SB(1, 0), b3, voffB);
            PG8_BAR; PG8_WAIT_L(0); PG8_MMA(0, 1, At, B1); PG8_BAR;
            PG8_LDA(At, 1, 1); PG8_STAGE(PG8_SA(1, 0), a3, voffA);
            PG8_BAR; PG8_WAIT_L(0); PG8_MMA(1, 0, At, B0); PG8_BAR; PG8_SCHED;
            PG8_STAGE(PG8_SB(1, 1), b3 + hB, voffB);
            PG8_WAIT_V(6); PG8_BAR; PG8_MMA(1, 1, At, B1); PG8_BAR;
            }
        }
        if constexpr (ALIGN_EPI) { if (wr == 0) PG8_BAR; }
        E(acc, cur, wr, wc, fr, fq);
        if (!has_next) break;
#pragma unroll
        for (int a = 0; a < 2; ++a)
#pragma unroll
            for (int b = 0; b < 2; ++b)
#pragma unroll
                for (int m = 0; m < 4; ++m)
#pragma unroll
                    for (int n = 0; n < 2; ++n) acc[a][b][m][n] = (f32x4){0.f, 0.f, 0.f, 0.f};
        cur = nxt; cA = nA; cB = nB; ++ui;
        if constexpr (ALIGN_EPI) { if (wr == 1) PG8_BAR; }
    }
    PG8_WAIT_V(0);
    if constexpr (!ALIGN_EPI) { if (wr == 0) PG8_BAR; }
    PG8_BAR;
#undef PG8_SA
#undef PG8_SB
#undef PG8_STAGE
#undef PG8_LDA
#undef PG8_LDB
#undef PG8_MMA
#undef PG8_WAIT_V
#undef PG8_WAIT_L
#undef PG8_BAR
#undef PG8_SCHED
}
}

using pg8::Unit;
#define PG8_LAS_T __attribute__((address_space(3)))

struct ProbPlain {
    const bf16* A; const bf16* Bt; int K, lda, ldb;
    __device__ __forceinline__ const char* a_ptr(const Unit& u) const { return (const char*)(A + (size_t)u.pm * 256 * lda); }
    __device__ __forceinline__ const char* b_ptr(const Unit& u) const { return (const char*)(Bt + (size_t)u.pn * 256 * ldb); }
};
struct ProbChanDft {
    const bf16* Wc; const bf16* XF; int K, lda, ldb; int seq; size_t tok0;
    __device__ __forceinline__ const char* a_ptr(const Unit& u) const { const int z = u.pm >> 1, pmi = u.pm & 1, g = z & 7; const int part = (u.pn * 512 >= seq) ? 1 : 0;
        return (const char*)(Wc + (((size_t)g * 2 + part) * 512 + pmi * 256) * GDIM); }
    __device__ __forceinline__ const char* b_ptr(const Unit& u) const { const int z = u.pm >> 1, g = z & 7, b = z >> 3; return (const char*)(XF + (tok0 + (size_t)b * seq + (size_t)u.pn * 256) * DM + g * GDIM); }
};
struct ProbSeqDft {
    const bf16* Dm; const bf16* YT; int K, lda, ldb; int tps;
    __device__ __forceinline__ const char* a_ptr(const Unit& u) const { const int pmi = u.pm % tps; return (const char*)(Dm + (size_t)pmi * 256 * lda); }
    __device__ __forceinline__ const char* b_ptr(const Unit& u) const { const int b = u.pm / tps; return (const char*)(YT + (size_t)b * DM * ldb + (size_t)u.pn * 256 * ldb); }
};

struct EpiQKV {
    static constexpr bool PERM = true;
    bf16* O; const u64* ss; const float* rcos; const float* rsin; mutable int cpm; mutable float crs[2][4];
    PG8_LAS_T unsigned char* ropel;
    __device__ __forceinline__ void operator()(const f32x4 (&acc)[2][2][4][2], const Unit& u, int wr, int wc, int fr, int fq) const {
        const int row0 = u.pm * 256 + wr * 64 + fr, col0 = u.pn * 256 + wc * 32 + 8 * fq;
        const bool rope = (u.pn < 32) && (wc == 0);
        const float sgn = fq < 2 ? -1.f : 1.f;
        const float qs = u.pn < DM / 256 ? QK_LOG2_SCALE : 1.f;
        if (u.pm != cpm) {
            cpm = u.pm; u64 sq[2][4];
#pragma unroll
            for (int ai = 0; ai < 2; ++ai)
#pragma unroll
                for (int m = 0; m < 4; ++m) sq[ai][m] = ss[row0 + ai * 128 + m * 16];
#pragma unroll
            for (int ai = 0; ai < 2; ++ai)
#pragma unroll
                for (int m = 0; m < 4; ++m) crs[ai][m] = ss_rstd(sq[ai][m]);
            { const int tid = threadIdx.x, r = tid >> 1, part = tid & 1, grow = u.pm * 256 + r; const int pos = grow < NTOK_P ? (grow & (SEQ_P - 1)) : (grow & (SEQ_S - 1));
              const f32x4* src = (const f32x4*)((part ? rsin : rcos) + pos * 16);
              const f32x4 t0 = src[0], t1 = src[1], t2 = src[2], t3 = src[3];
              typedef _Float16 h2 __attribute__((ext_vector_type(2)));
#define QKV_H2(a, b) ({ h2 hh = {(_Float16)(a), (_Float16)(b)}; *(unsigned*)&hh; })
              pg8::u32x4 w0 = {QKV_H2(t0[0], t0[1]), QKV_H2(t0[2], t0[3]), QKV_H2(t1[0], t1[1]), QKV_H2(t1[2], t1[3])}, w1 = {QKV_H2(t2[0], t2[1]), QKV_H2(t2[2], t2[3]), QKV_H2(t3[0], t3[1]), QKV_H2(t3[2], t3[3])};
#undef QKV_H2
              *(PG8_LAS_T pg8::u32x4*)(ropel + r * 64 + part * 32) = w0; *(PG8_LAS_T pg8::u32x4*)(ropel + r * 64 + part * 32 + 16) = w1; }
            asm volatile("s_waitcnt lgkmcnt(0)" ::: "memory"); __builtin_amdgcn_s_barrier(); asm volatile("" ::: "memory");
        }
#pragma unroll
        for (int am = 0; am < 4; ++am) { const int ai = am >> 1;
            f32x4 c0[4], c1[4], s0[4], s1[4];
            if (rope) {
#pragma unroll
                for (int m = 2 * (am & 1); m < 2 * (am & 1) + 2; ++m) { const int lr = wr * 64 + fr + ai * 128 + m * 16;
                    typedef _Float16 h8 __attribute__((ext_vector_type(8)));
                    const h8 hc = *(const PG8_LAS_T h8*)(ropel + lr * 64 + (fq & 1) * 16), hs = *(const PG8_LAS_T h8*)(ropel + lr * 64 + 32 + (fq & 1) * 16);
                    c0[m] = (f32x4){(float)hc[0], (float)hc[1], (float)hc[2], (float)hc[3]}; c1[m] = (f32x4){(float)hc[4], (float)hc[5], (float)hc[6], (float)hc[7]};
                    s0[m] = (f32x4){(float)hs[0], (float)hs[1], (float)hs[2], (float)hs[3]}; s1[m] = (f32x4){(float)hs[4], (float)hs[5], (float)hs[6], (float)hs[7]}; }
            }
#pragma unroll
            for (int m = 2 * (am & 1); m < 2 * (am & 1) + 2; ++m) {
                const int row = row0 + ai * 128 + m * 16;
                const float rs = crs[ai][m] * qs;
                bf16* rowp = O + (size_t)row * NQKV + col0;
#pragma unroll
                for (int bj = 0; bj < 2; ++bj) {
                    f32x4 v0 = acc[ai][bj][m][0] * rs, v1 = acc[ai][bj][m][1] * rs;
                    if (rope) {
                        f32x4 p0, p1;
#pragma unroll
                        for (int j = 0; j < 4; ++j) { p0[j] = __shfl_xor(v0[j], 32); p1[j] = __shfl_xor(v1[j], 32); }
                        v0 = v0 * c0[m] + p0 * (s0[m] * sgn); v1 = v1 * c1[m] + p1 * (s1[m] * sgn);
                    }
                    pg8::u32x4 w; w.x = cvt_pk_bf16(v0[0], v0[1]); w.y = cvt_pk_bf16(v0[2], v0[3]); w.z = cvt_pk_bf16(v1[0], v1[1]); w.w = cvt_pk_bf16(v1[2], v1[3]);
                    *(pg8::u32x4*)(rowp + bj * 128) = w;
                }
            }
        }
    }
};

struct EpiRes {
    static constexpr bool PERM = true;
    bf16* xb; u64* ss;
    __device__ __forceinline__ void operator()(const f32x4 (&acc)[2][2][4][2], const Unit& u, int wr, int wc, int fr, int fq) const {
        const int row0 = u.pm * 256 + wr * 64 + fr, col0 = u.pn * 256 + wc * 32 + 8 * fq;
        bf16* base = xb + (size_t)row0 * DM + col0;
        pg8::u32x4 r[2][4][2];
#pragma unroll
        for (int ai = 0; ai < 2; ++ai)
#pragma unroll
            for (int m = 0; m < 4; ++m)
#pragma unroll
                for (int bj = 0; bj < 2; ++bj) r[ai][m][bj] = *(const pg8::u32x4*)(base + (size_t)(ai * 128 + m * 16) * DM + bj * 128);
#pragma unroll
        for (int ai = 0; ai < 2; ++ai)
#pragma unroll
            for (int m = 0; m < 4; ++m) {
                const int row = row0 + ai * 128 + m * 16; bf16* rowp = base + (size_t)(ai * 128 + m * 16) * DM;
                float s = 0.f;
#pragma unroll
                for (int bj = 0; bj < 2; ++bj) {
                    const pg8::u32x4 q = r[ai][m][bj];
                    const f32x4 v0 = acc[ai][bj][m][0] + (f32x4){bf_lo(q.x), bf_hi(q.x), bf_lo(q.y), bf_hi(q.y)}, v1 = acc[ai][bj][m][1] + (f32x4){bf_lo(q.z), bf_hi(q.z), bf_lo(q.w), bf_hi(q.w)};
                    pg8::u32x4 w; w.x = cvt_pk_bf16(v0[0], v0[1]); w.y = cvt_pk_bf16(v0[2], v0[3]); w.z = cvt_pk_bf16(v1[0], v1[1]); w.w = cvt_pk_bf16(v1[2], v1[3]);
                    *(pg8::u32x4*)(rowp + bj * 128) = w;
                    s += ((v0[0] * v0[0] + v0[1] * v0[1]) + (v0[2] * v0[2] + v0[3] * v0[3])) + ((v1[0] * v1[0] + v1[1] * v1[1]) + (v1[2] * v1[2] + v1[3] * v1[3]));
                }
                s += __shfl_xor(s, 16); s += __shfl_xor(s, 32);
                if (fq == 0) __hip_atomic_fetch_add(ss + row, ss_fix(s), __ATOMIC_RELAXED, __HIP_MEMORY_SCOPE_AGENT);
            }
    }
};

struct EpiGateUp {
    static constexpr bool PERM = true;
    bf16* H; const u64* ss; mutable int cpm; mutable float crs[2][4];
    __device__ __forceinline__ void operator()(const f32x4 (&acc)[2][2][4][2], const Unit& u, int wr, int wc, int fr, int fq) const {
        const int row0 = u.pm * 256 + wr * 64 + fr, col0 = u.pn * 128 + wc * 32 + 8 * fq;
        if (u.pm != cpm) {
            cpm = u.pm; u64 sq[2][4];
#pragma unroll
            for (int ai = 0; ai < 2; ++ai)
#pragma unroll
                for (int m = 0; m < 4; ++m) sq[ai][m] = ss[row0 + ai * 128 + m * 16];
#pragma unroll
            for (int ai = 0; ai < 2; ++ai)
#pragma unroll
                for (int m = 0; m < 4; ++m) crs[ai][m] = ss_rstd(sq[ai][m]);
        }
#pragma unroll
        for (int ai = 0; ai < 2; ++ai)
#pragma unroll
            for (int m = 0; m < 4; ++m) {
                const int row = row0 + ai * 128 + m * 16;
                const float rs = crs[ai][m], rs2 = rs * rs, rse = -1.4426950408889634f * rs;
                float h[8];
#pragma unroll
                for (int n = 0; n < 2; ++n)
#pragma unroll
                    for (int j = 0; j < 4; ++j) { const float ga = acc[ai][0][m][n][j], ua = acc[ai][1][m][n][j];
                        h[n * 4 + j] = (ga * ua) * __builtin_amdgcn_rcpf(1.f + __builtin_amdgcn_exp2f(rse * ga)) * rs2; }
                pg8::u32x4 w; w.x = cvt_pk_bf16(h[0], h[1]); w.y = cvt_pk_bf16(h[2], h[3]); w.z = cvt_pk_bf16(h[4], h[5]); w.w = cvt_pk_bf16(h[6], h[7]);
                *(pg8::u32x4*)(H + (size_t)row * DFF + col0) = w;
            }
    }
};

struct EpiSeqDft {
    static constexpr bool PERM = true;
    bf16* O; const float* avec; int tps;
    __device__ __forceinline__ void operator()(const f32x4 (&acc)[2][2][4][2], const Unit& u, int wr, int wc, int fr, int fq) const {
        const int row0 = u.pm * 256 + wr * 64 + fr, col0 = u.pn * 256 + wc * 32 + 8 * fq;
        const float* av = avec + (size_t)(u.pm / tps) * DM + col0;
        const float sg = (fr & 1) ? -1.f : 1.f;
        f32x4 a[2][2];
#pragma unroll
        for (int bj = 0; bj < 2; ++bj)
#pragma unroll
            for (int n = 0; n < 2; ++n) a[bj][n] = *(const f32x4*)(av + bj * 128 + 4 * n) * sg;
#pragma unroll
        for (int ai = 0; ai < 2; ++ai)
#pragma unroll
            for (int m = 0; m < 4; ++m) { bf16* rowp = O + (size_t)(row0 + ai * 128 + m * 16) * DM + col0;
#pragma unroll
                for (int bj = 0; bj < 2; ++bj) { const f32x4 v0 = acc[ai][bj][m][0] + a[bj][0], v1 = acc[ai][bj][m][1] + a[bj][1];
                    pg8::u32x4 w; w.x = cvt_pk_bf16(v0[0], v0[1]); w.y = cvt_pk_bf16(v0[2], v0[3]); w.z = cvt_pk_bf16(v1[0], v1[1]); w.w = cvt_pk_bf16(v1[2], v1[3]);
                    *(pg8::u32x4*)(rowp + bj * 128) = w; } }
    }
};

struct ProbSeqDftH {
    const bf16* Dm; const bf16* YT; int K, lda, ldb; int tps; int koff;
    __device__ __forceinline__ const char* a_ptr(const Unit& u) const { const int pmi = u.pm % tps; return (const char*)(Dm + (size_t)pmi * 256 * lda + koff); }
    __device__ __forceinline__ const char* b_ptr(const Unit& u) const { const int b = u.pm / tps; return (const char*)(YT + (size_t)b * DM * ldb + (size_t)u.pn * 256 * ldb + koff); }
};
struct EpiSeqE {
    static constexpr bool PERM = true;
    bf16* E; const float* avec; int tps;
    __device__ __forceinline__ void operator()(const f32x4 (&acc)[2][2][4][2], const Unit& u, int wr, int wc, int fr, int fq) const {
        const int row0 = u.pm * 256 + wr * 64 + fr, col0 = u.pn * 256 + wc * 32 + 8 * fq;
        const float* av = avec + (size_t)(u.pm / tps) * DM + col0;
        const float sg = (fr & 1) ? -1.f : 1.f;
        f32x4 a[2][2];
#pragma unroll
        for (int bj = 0; bj < 2; ++bj)
#pragma unroll
            for (int n = 0; n < 2; ++n) a[bj][n] = *(const f32x4*)(av + bj * 128 + 4 * n) * sg;
#pragma unroll
        for (int ai = 0; ai < 2; ++ai)
#pragma unroll
            for (int m = 0; m < 4; ++m) { bf16* rowp = E + (size_t)(row0 + ai * 128 + m * 16) * DM + col0;
#pragma unroll
                for (int bj = 0; bj < 2; ++bj) { const f32x4 v0 = acc[ai][bj][m][0] + a[bj][0], v1 = acc[ai][bj][m][1] + a[bj][1];
                    pg8::u32x4 w; w.x = cvt_pk_bf16(v0[0], v0[1]); w.y = cvt_pk_bf16(v0[2], v0[3]); w.z = cvt_pk_bf16(v1[0], v1[1]); w.w = cvt_pk_bf16(v1[2], v1[3]);
                    *(pg8::u32x4*)(rowp + bj * 128) = w; } }
    }
};
struct EpiSeqO {
    static constexpr bool PERM = true;
    const bf16* E; bf16* F; int tps; int S;
    __device__ __forceinline__ void operator()(const f32x4 (&acc)[2][2][4][2], const Unit& u, int wr, int wc, int fr, int fq) const {
        const int row0 = u.pm * 256 + wr * 64 + fr, col0 = u.pn * 256 + wc * 32 + 8 * fq;
        const int b = u.pm / tps, n0 = (u.pm % tps) * 256 + wr * 64 + fr;
#pragma unroll
        for (int ai = 0; ai < 2; ++ai) {
            pg8::u32x4 eq[4][2];
#pragma unroll
            for (int m = 0; m < 4; ++m) { const bf16* ep = E + (size_t)(row0 + ai * 128 + m * 16) * DM + col0;
#pragma unroll
                for (int bj = 0; bj < 2; ++bj) eq[m][bj] = *(const pg8::u32x4*)(ep + bj * 128); }
#pragma unroll
            for (int m = 0; m < 4; ++m) { const int n = n0 + ai * 128 + m * 16;
                bf16* rp = F + ((size_t)b * S + n) * DM + col0; bf16* rm = F + ((size_t)b * S + (S - n)) * DM + col0;
#pragma unroll
                for (int bj = 0; bj < 2; ++bj) { const pg8::u32x4 q = eq[m][bj];
                    const f32x4 e0 = {bf_lo(q.x), bf_hi(q.x), bf_lo(q.y), bf_hi(q.y)}, e1 = {bf_lo(q.z), bf_hi(q.z), bf_lo(q.w), bf_hi(q.w)};
                    const f32x4 p0 = e0 + acc[ai][bj][m][0], p1 = e1 + acc[ai][bj][m][1], q0 = e0 - acc[ai][bj][m][0], q1 = e1 - acc[ai][bj][m][1];
                    pg8::u32x4 w; w.x = cvt_pk_bf16(p0[0], p0[1]); w.y = cvt_pk_bf16(p0[2], p0[3]); w.z = cvt_pk_bf16(p1[0], p1[1]); w.w = cvt_pk_bf16(p1[2], p1[3]);
                    *(pg8::u32x4*)(rp + bj * 128) = w;
                    if (n > 0) { pg8::u32x4 x; x.x = cvt_pk_bf16(q0[0], q0[1]); x.y = cvt_pk_bf16(q0[2], q0[3]); x.z = cvt_pk_bf16(q1[0], q1[1]); x.w = cvt_pk_bf16(q1[2], q1[3]);
                        *(pg8::u32x4*)(rm + bj * 128) = x; } } }
        }
    }
};

struct EpiBf16Plain {
    static constexpr bool PERM = true;
    bf16* O; int ldc;
    __device__ __forceinline__ void operator()(const f32x4 (&acc)[2][2][4][2], const Unit& u, int wr, int wc, int fr, int fq) const {
        const int row0 = u.pm * 256 + wr * 64 + fr, col0 = u.pn * 256 + wc * 32 + 8 * fq;
#pragma unroll
        for (int ai = 0; ai < 2; ++ai)
#pragma unroll
            for (int m = 0; m < 4; ++m) { bf16* rowp = O + (size_t)(row0 + ai * 128 + m * 16) * ldc + col0;
#pragma unroll
                for (int bj = 0; bj < 2; ++bj) { const f32x4 v0 = acc[ai][bj][m][0], v1 = acc[ai][bj][m][1];
                    pg8::u32x4 w; w.x = cvt_pk_bf16(v0[0], v0[1]); w.y = cvt_pk_bf16(v0[2], v0[3]); w.z = cvt_pk_bf16(v1[0], v1[1]); w.w = cvt_pk_bf16(v1[2], v1[3]);
                    *(pg8::u32x4*)(rowp + bj * 128) = w; } }
    }
};

namespace attn {
constexpr int D = 128, NW = 8, QBLK = 32, KVBLK = 64;
constexpr float SCALE = 0.088388347648318440f;
constexpr float THR = 8.f;
using s16x4  = __attribute__((ext_vector_type(4))) short;
using f32x16 = __attribute__((ext_vector_type(16))) float;
#define KSWZ(row, colB) ((row) * 256 + ((colB) ^ (((row) & 7) << 4)))
#define SBAR() __builtin_amdgcn_sched_barrier(0)
__device__ __forceinline__ int crow(int r, int hi) { return (r & 3) + 8 * (r >> 2) + 4 * hi; }
__device__ __forceinline__ unsigned cvtpk(float lo, float hi) { unsigned r; asm volatile("v_cvt_pk_bf16_f32 %0, %1, %2" : "=v"(r) : "v"(lo), "v"(hi)); return r; }

__device__ __forceinline__ void partialSM(f32x16& p0, f32x16& p1, float& m_reg, float& mn, float& alpha) {
  constexpr float C = SCALE * 1.4426950408889634f;
  float pmax = p0[0]; for (int r = 1; r < 16; ++r) pmax = fmaxf(pmax, p0[r]); for (int r = 0; r < 16; ++r) pmax = fmaxf(pmax, p1[r]);
  { auto rr = __builtin_amdgcn_permlane32_swap(__float_as_uint(pmax), __float_as_uint(pmax), false, false);
    pmax = fmaxf(__uint_as_float(rr[0]), __uint_as_float(rr[1])); }
  if (__builtin_expect(__all(pmax - m_reg <= THR / SCALE), 1)) { mn = m_reg; alpha = 1.f; }
  else { mn = fmaxf(m_reg, pmax); alpha = __builtin_amdgcn_exp2f((m_reg - mn) * C); m_reg = mn; }
  float mnC = -mn * C;
  for (int r = 0; r < 16; ++r) p0[r] = fmaf(p0[r], C, mnC); for (int r = 0; r < 16; ++r) p1[r] = fmaf(p1[r], C, mnC);
  for (int r = 0; r < 16; ++r) p0[r] = __builtin_amdgcn_exp2f(p0[r]);
}
__device__ __forceinline__ void finishSM(f32x16& p0, f32x16& p1, float alpha, float& l_reg, bf16x8& pa0, bf16x8& pa1, bf16x8& pa2, bf16x8& pa3) {
  for (int r = 0; r < 16; ++r) p1[r] = __builtin_amdgcn_exp2f(p1[r]);
  float ps = 0; for (int r = 0; r < 16; ++r) ps += p0[r]; for (int r = 0; r < 16; ++r) ps += p1[r];
  { auto rr = __builtin_amdgcn_permlane32_swap(__float_as_uint(ps), __float_as_uint(ps), false, false);
    ps = __uint_as_float(rr[0]) + __uint_as_float(rr[1]); }
  l_reg = l_reg * alpha + ps;
#define PK4(P, BASE, OUT) do { unsigned a0 = cvtpk(P[BASE + 0], P[BASE + 1]), a1 = cvtpk(P[BASE + 2], P[BASE + 3]);   \
    unsigned b0 = cvtpk(P[BASE + 4], P[BASE + 5]), b1 = cvtpk(P[BASE + 6], P[BASE + 7]);                              \
    auto r0 = __builtin_amdgcn_permlane32_swap(a0, b0, false, false); auto r1 = __builtin_amdgcn_permlane32_swap(a1, b1, false, false); \
    v4u w = {r0[0], r1[0], r0[1], r1[1]}; OUT = *reinterpret_cast<bf16x8*>(&w); } while (0)
  PK4(p0, 0, pa0); PK4(p0, 8, pa1); PK4(p1, 0, pa2); PK4(p1, 8, pa3);
#undef PK4
}
__device__ __forceinline__ void qkt(f32x16& p0, f32x16& p1, const bf16* Ks, const bf16x8* qr, int r32, int hi) {
  p0 = f32x16{}; p1 = f32x16{};
  for (int d0 = 0; d0 < 8; ++d0) { int cb = (d0 * 16 + hi * 8) * 2;
    bf16x8 b0 = *reinterpret_cast<const bf16x8*>((const char*)Ks + KSWZ(r32, cb));
    bf16x8 b1 = *reinterpret_cast<const bf16x8*>((const char*)Ks + KSWZ(32 + r32, cb));
    p0 = __builtin_amdgcn_mfma_f32_32x32x16_bf16(b0, qr[d0], p0, 0, 0, 0);
    p1 = __builtin_amdgcn_mfma_f32_32x32x16_bf16(b1, qr[d0], p1, 0, 0, 0); }
}
__device__ __forceinline__ int v_st(int k, int c) { const int kk = (k & ~0xC) | ((k & 4) << 1) | ((k & 8) >> 1); return ((kk >> 3) * 4 + (c >> 5)) * 512 + ((kk & 7) * 32 + (c & 31)) * 2; }
__device__ __forceinline__ int v_rd_base(int lane) { return ((lane & 3) << 3) | (((lane >> 2) & 3) << 6) | (((lane >> 4) & 1) << 5) | (((lane >> 5) & 1) << 8); }
constexpr int v_rd_off(int d0, int ks, int half) { return d0 * 512 + ks * 4096 + half * 2048; }
template <int OFF> __device__ __forceinline__ s16x4 tr_read(int vb) {
  s16x4 r; asm volatile("ds_read_b64_tr_b16 %0, %1 offset:%2" : "=&v"(r) : "v"(vb), "i"(OFF) : "memory"); return r;
}
template <int D0> __device__ __forceinline__ void pv_one(f32x16& od, int vb, bf16x8 pa0, bf16x8 pa1, bf16x8 pa2, bf16x8 pa3) {
  const s16x4 l0 = tr_read<v_rd_off(D0, 0, 0)>(vb), h0 = tr_read<v_rd_off(D0, 0, 1)>(vb), l1 = tr_read<v_rd_off(D0, 1, 0)>(vb), h1 = tr_read<v_rd_off(D0, 1, 1)>(vb);
  const s16x4 l2 = tr_read<v_rd_off(D0, 2, 0)>(vb), h2 = tr_read<v_rd_off(D0, 2, 1)>(vb), l3 = tr_read<v_rd_off(D0, 3, 0)>(vb), h3 = tr_read<v_rd_off(D0, 3, 1)>(vb);
  asm volatile("s_waitcnt lgkmcnt(0)" ::: "memory"); SBAR();
#define PK(L, H) (bf16x8){L[0], L[1], L[2], L[3], H[0], H[1], H[2], H[3]}
  od = __builtin_amdgcn_mfma_f32_32x32x16_bf16(pa0, PK(l0, h0), od, 0, 0, 0);
  od = __builtin_amdgcn_mfma_f32_32x32x16_bf16(pa1, PK(l1, h1), od, 0, 0, 0);
  od = __builtin_amdgcn_mfma_f32_32x32x16_bf16(pa2, PK(l2, h2), od, 0, 0, 0);
  od = __builtin_amdgcn_mfma_f32_32x32x16_bf16(pa3, PK(l3, h3), od, 0, 0, 0);
#undef PK
}
__device__ __forceinline__ void pv_d0(f32x16* o, int vb, bf16x8 pa0, bf16x8 pa1, bf16x8 pa2, bf16x8 pa3) {
  pv_one<0>(o[0], vb, pa0, pa1, pa2, pa3); pv_one<1>(o[1], vb, pa0, pa1, pa2, pa3); pv_one<2>(o[2], vb, pa0, pa1, pa2, pa3); pv_one<3>(o[3], vb, pa0, pa1, pa2, pa3);
}

}

namespace attn2 {
using namespace attn;
constexpr int K_OFF = 0, V_OFF = 32768, P_OFF = 98304, X_OFF = 131072, LDS_ATTN2 = X_OFF + 4096;
__device__ __forceinline__ int opaque0() { int z = 0; asm volatile("" : "+v"(z)); return z; }
#define A2_BAR() do { asm volatile("s_waitcnt lgkmcnt(0)" ::: "memory"); __builtin_amdgcn_s_barrier(); asm volatile("" ::: "memory"); } while (0)

__device__ __forceinline__ void unit(const bf16* __restrict__ kvb, int q0, int seq, bf16* __restrict__ Oc, float lam, unsigned* __restrict__ stash, char* lds) {
  const int tid = threadIdx.x, wid = __builtin_amdgcn_readfirstlane(tid >> 6), lane = tid & 63, hi = lane >> 5;
  const int p = wid & 3, NT = seq / KVBLK;
  char* Kl = lds + K_OFF; char* Vl = lds + V_OFF; char* Pl = lds + P_OFF + p * 8192;
  float* X = (float*)(lds + X_OFF + p * 1024);
  for (int pass = 0; pass < 2; ++pass) {
    const int c = 1 - pass;
    const bf16* Kg = kvb + DM + c * 128; const bf16* Vg = kvb + 2 * DM;
    if (wid < 4) {
      const int zA = opaque0(); const int r32 = (lane & 31) + zA, lanea = lane + zA;
      bf16x8 qr[8];
      const bf16* Qw = kvb + (long)(q0 + p * 32 + r32) * NQKV + c * 128 + hi * 8;
#pragma unroll
      for (int d0 = 0; d0 < 8; ++d0) qr[d0] = *reinterpret_cast<const bf16x8*>(Qw + d0 * 16);
      float l_reg = 0.f;
      f32x16 cinit;
#pragma unroll
      for (int r = 0; r < 16; ++r) cinit[r] = 0.f;
      A2_BAR();
      for (int s = 0; s < NT; ++s) {
        f32x16 p0, p1;
        { const char* Ks = Kl + (s & 1) * 16384;
#pragma unroll
          for (int d0 = 0; d0 < 8; ++d0) { const int cb = (d0 * 16 + hi * 8) * 2;
            const bf16x8 b0 = *reinterpret_cast<const bf16x8*>(Ks + KSWZ(r32, cb)), b1 = *reinterpret_cast<const bf16x8*>(Ks + KSWZ(32 + r32, cb));
            p0 = __builtin_amdgcn_mfma_f32_32x32x16_bf16(b0, qr[d0], d0 == 0 ? cinit : p0, 0, 0, 0);
            p1 = __builtin_amdgcn_mfma_f32_32x32x16_bf16(b1, qr[d0], d0 == 0 ? cinit : p1, 0, 0, 0); } }
        float pmax = fmaxf(p0[0], p1[0]);
#pragma unroll
        for (int r = 1; r < 16; ++r) pmax = fmaxf(fmaxf(pmax, p0[r]), p1[r]);
        { auto rr = __builtin_amdgcn_permlane32_swap(__float_as_uint(pmax), __float_as_uint(pmax), false, false);
          pmax = fmaxf(__uint_as_float(rr[0]), __uint_as_float(rr[1])); }
        float alpha = 1.f;
        if (__builtin_expect(s == 0 || !__all(pmax <= THR * 1.4426950408889634f), 0)) {
          const float d = s == 0 ? pmax : fmaxf(pmax, 0.f);
          alpha = s == 0 ? 1.f : __builtin_amdgcn_exp2f(-d);
#pragma unroll
          for (int r = 0; r < 16; ++r) { p0[r] -= d; p1[r] -= d; cinit[r] -= d; }
        }
#pragma unroll
        for (int r = 0; r < 16; ++r) { p0[r] = __builtin_amdgcn_exp2f(p0[r]); p1[r] = __builtin_amdgcn_exp2f(p1[r]); }
        unsigned u0[8], u1[8];
#pragma unroll
        for (int r = 0; r < 8; ++r) { u0[r] = cvtpk(p0[2 * r], p0[2 * r + 1]); u1[r] = cvtpk(p1[2 * r], p1[2 * r + 1]); }
        float ps = p0[0] + p1[0];
#pragma unroll
        for (int r = 1; r < 16; ++r) ps += p0[r] + p1[r];
        { auto rr = __builtin_amdgcn_permlane32_swap(__float_as_uint(ps), __float_as_uint(ps), false, false);
          ps = __uint_as_float(rr[0]) + __uint_as_float(rr[1]); }
        l_reg = l_reg * alpha + ps;
        { char* Ps = Pl + (s & 1) * 4096 + (lanea & 31) * 16 + (lanea >> 5) * 8;
          *(v2u*)(Ps)        = (v2u){u0[0], u0[1]}; *(v2u*)(Ps + 512)        = (v2u){u0[2], u0[3]};
          *(v2u*)(Ps + 1024) = (v2u){u0[4], u0[5]}; *(v2u*)(Ps + 1024 + 512) = (v2u){u0[6], u0[7]};
          *(v2u*)(Ps + 2048) = (v2u){u1[0], u1[1]}; *(v2u*)(Ps + 2048 + 512) = (v2u){u1[2], u1[3]};
          *(v2u*)(Ps + 3072) = (v2u){u1[4], u1[5]}; *(v2u*)(Ps + 3072 + 512) = (v2u){u1[6], u1[7]}; }
        const bool resc = __any(alpha < 1.f);
        if (resc && hi == 0) X[(s & 1) * 32 + r32] = alpha;
        if (lane == 0) ((unsigned*)X)[64 + (s & 1)] = resc ? 1u : 0u;
        A2_BAR();
      }
      if (hi == 0) X[128 + r32] = l_reg;
      A2_BAR();
      if (pass == 1) A2_BAR();
    } else {
      const int zB = opaque0(); const int laneb = lane + zB;
      const int bw = wid - 4, g = laneb >> 4, q16 = laneb & 15, pq = (laneb & 15) >> 2, pp = laneb & 3;
      unsigned voffK[4], voffV[4];
#pragma unroll
      for (int i = 0; i < 4; ++i) {
        const int key = 16 * bw + 4 * i + (laneb >> 4), cch = (laneb & 15) ^ ((4 * i + (laneb >> 4)) & 7);
        voffK[i] = (unsigned)(key * NQKV + cch * 8) * 2u;
        const int g8 = 2 * bw + (i >> 1), chq = ((i & 1) << 1) + (laneb >> 5), r7 = (laneb >> 2) & 7, cx = laneb & 3;
        const int vkey = 8 * g8 + r7, vch = 4 * chq + (cx ^ (2 * (g8 & 1) + (r7 >> 2)));
        voffV[i] = (unsigned)(vkey * NQKV + vch * 8) * 2u;
      }
      const char* Kgb = (const char*)Kg; const char* Vgb = (const char*)Vg;
      LAS unsigned char* Kd = (LAS unsigned char*)(Kl) + bw * 4096; LAS unsigned char* Vd = (LAS unsigned char*)(Vl) + bw * 4096;
#define A2_DMAK(tile, slot) do { _Pragma("unroll") for (int i = 0; i < 4; ++i) \
        __builtin_amdgcn_global_load_lds((const unsigned*)(Kgb + (size_t)(tile) * (KVBLK * NQKV * 2) + voffK[i]), (LAS unsigned*)(Kd + (slot) * 16384 + i * 1024), 16, 0, 0); } while (0)
#define A2_DMAV(tile, slot) do { _Pragma("unroll") for (int e = 0; e < 2; ++e) _Pragma("unroll") for (int i = 0; i < 4; ++i) \
        __builtin_amdgcn_global_load_lds((const unsigned*)(Vgb + (size_t)(tile) * (KVBLK * NQKV * 2) + e * 256 + voffV[i]), (LAS unsigned*)(Vd + (slot) * 32768 + e * 16384 + i * 1024), 16, 0, 0); } while (0)
#define A2_BARV() do { asm volatile("s_waitcnt vmcnt(0) lgkmcnt(0)" ::: "memory"); __builtin_amdgcn_s_barrier(); asm volatile("" ::: "memory"); } while (0)
#define A2_DMA1(vo, sbase, ldsaddr) asm volatile("s_mov_b32 m0, %2\n\ts_nop 0\n\tglobal_load_lds_dwordx4 %0, %1" :: "v"(vo), "s"(sbase), "s"(ldsaddr) : "memory", "m0")
#define A2_K1(i, tile, slot) A2_DMA1(voffK[i], Kgb + (size_t)(tile) * (KVBLK * NQKV * 2), (unsigned)(uintptr_t)(Kd + (slot) * 16384 + (i) * 1024))
#define A2_V1(e, i, tile, slot) A2_DMA1(voffV[i], Vgb + (size_t)(tile) * (KVBLK * NQKV * 2) + (e) * 256, (unsigned)(uintptr_t)(Vd + (slot) * 32768 + (e) * 16384 + (i) * 1024))
#define A2_RD16(F, B0, B1, IMM) do { F[0] = tr_read<(IMM)>(B0); F[1] = tr_read<(IMM) + 256>(B1); } while (0)
#define A2_WL(n) do { asm volatile("s_waitcnt lgkmcnt(" #n ")" ::: "memory"); SBAR(); } while (0)
#define A2_MM16(OA, OB, F, PA, PB) do { const bf16x8 _v = (bf16x8){F[0][0], F[0][1], F[0][2], F[0][3], F[1][0], F[1][1], F[1][2], F[1][3]}; \
        OA = __builtin_amdgcn_mfma_f32_16x16x32_bf16(_v, PA, OA, 0, 0, 0); OB = __builtin_amdgcn_mfma_f32_16x16x32_bf16(_v, PB, OB, 0, 0, 0); SBAR(); } while (0)
      const int rh = bw >> 1, ch = bw & 1;
      char* PlA0 = lds + P_OFF + (2 * rh) * 8192; char* PlA1 = PlA0 + 8192;
      float* XA0 = (float*)(lds + X_OFF + (2 * rh) * 1024); float* XA1 = XA0 + 256;
      f32x4 oacc[8][4];
#pragma unroll
      for (int cc = 0; cc < 8; ++cc)
#pragma unroll
        for (int qb = 0; qb < 4; ++qb) oacc[cc][qb] = (f32x4){0.f, 0.f, 0.f, 0.f};
      const int vrel = 2048 * g + 64 * pq + 8 * (pp & 1) + ch * 16384;
      const int vr00 = vrel + 32 * (0 ^ (g & 1)) + 16 * ((pp >> 1) ^ 0), vr01 = vrel + 32 * (0 ^ (g & 1)) + 16 * ((pp >> 1) ^ 1);
      const int vr10 = vrel + 32 * (1 ^ (g & 1)) + 16 * ((pp >> 1) ^ 0), vr11 = vrel + 32 * (1 ^ (g & 1)) + 16 * ((pp >> 1) ^ 1);
      const int prel0 = (g >> 1) * 1024 + (q16 + 32 * (g & 1)) * 16;
      A2_DMAK(0, 0);
      A2_BARV();
      { const int kt = 1 < NT ? 1 : 0; A2_DMAK(kt, 1); A2_DMAV(0, 0); }
      A2_BARV();
      for (int s = 1; s <= NT; ++s) {
        const int kt = (s + 1 < NT) ? s + 1 : NT - 1, ks = (s + 1) & 1;
        const int vt = (s < NT) ? s : NT - 1, vs = s & 1;
        const bool kdo = s + 1 < NT, vdo = s < NT;
        const int t = (s - 1) & 1;
        bf16x8 pf[4][2];
        { const char* P0 = PlA0 + t * 4096 + prel0; const char* P1 = PlA1 + t * 4096 + prel0;
          pf[0][0] = *(const bf16x8*)(P0); pf[0][1] = *(const bf16x8*)(P0 + 2048); pf[1][0] = *(const bf16x8*)(P0 + 256); pf[1][1] = *(const bf16x8*)(P0 + 2048 + 256);
          pf[2][0] = *(const bf16x8*)(P1); pf[2][1] = *(const bf16x8*)(P1 + 2048); pf[3][0] = *(const bf16x8*)(P1 + 256); pf[3][1] = *(const bf16x8*)(P1 + 2048 + 256); }
        const unsigned fl0 = *((volatile LAS unsigned*)XA0 + 64 + t), fl1 = *((volatile LAS unsigned*)XA1 + 64 + t);
        if (fl0 | fl1) {
          const float a0 = fl0 ? XA0[t * 32 + q16] : 1.f, a1 = fl0 ? XA0[t * 32 + 16 + q16] : 1.f, a2 = fl1 ? XA1[t * 32 + q16] : 1.f, a3 = fl1 ? XA1[t * 32 + 16 + q16] : 1.f;
#pragma unroll
          for (int cc = 0; cc < 8; ++cc) { oacc[cc][0] *= a0; oacc[cc][1] *= a1; oacc[cc][2] *= a2; oacc[cc][3] *= a3; }
        }
        const int vsl = (int)(uintptr_t)(Vl + t * 32768);
        const int vb00 = vsl + vr00, vb01 = vsl + vr01, vb10 = vsl + vr10, vb11 = vsl + vr11;
        s16x4 F0[2], F1[2], F2[2], F3[2];
#define A2_MM4(CC, F, KB) do { const bf16x8 _v = (bf16x8){F[0][0], F[0][1], F[0][2], F[0][3], F[1][0], F[1][1], F[1][2], F[1][3]}; \
        oacc[CC][0] = __builtin_amdgcn_mfma_f32_16x16x32_bf16(_v, pf[0][KB], oacc[CC][0], 0, 0, 0); oacc[CC][1] = __builtin_amdgcn_mfma_f32_16x16x32_bf16(_v, pf[1][KB], oacc[CC][1], 0, 0, 0); \
        oacc[CC][2] = __builtin_amdgcn_mfma_f32_16x16x32_bf16(_v, pf[2][KB], oacc[CC][2], 0, 0, 0); oacc[CC][3] = __builtin_amdgcn_mfma_f32_16x16x32_bf16(_v, pf[3][KB], oacc[CC][3], 0, 0, 0); SBAR(); } while (0)
        A2_RD16(F0, vb00, vb01, 0); A2_RD16(F1, vb00, vb01, 8192); A2_RD16(F2, vb10, vb11, 0);
        A2_WL(4); A2_RD16(F3, vb10, vb11, 8192); if (kdo) { A2_K1(0, kt, ks); A2_K1(1, kt, ks); } A2_MM4(0, F0, 0);
        A2_WL(4); A2_RD16(F0, vb00, vb01, 512); if (kdo) { A2_K1(2, kt, ks); A2_K1(3, kt, ks); } A2_MM4(0, F1, 1);
        A2_WL(4); A2_RD16(F1, vb00, vb01, 8704); if (vdo) { A2_V1(0, 0, vt, vs); A2_V1(0, 1, vt, vs); } A2_MM4(1, F2, 0);
        A2_WL(4); A2_RD16(F2, vb10, vb11, 512); if (vdo) { A2_V1(0, 2, vt, vs); A2_V1(0, 3, vt, vs); } A2_MM4(1, F3, 1);
        A2_WL(4); A2_RD16(F3, vb10, vb11, 8704); if (vdo) { A2_V1(1, 0, vt, vs); A2_V1(1, 1, vt, vs); } A2_MM4(2, F0, 0);
        A2_WL(4); A2_RD16(F0, vb00, vb01, 1024); if (vdo) { A2_V1(1, 2, vt, vs); A2_V1(1, 3, vt, vs); } A2_MM4(2, F1, 1);
        A2_WL(4); A2_RD16(F1, vb00, vb01, 9216); A2_MM4(3, F2, 0);
        A2_WL(4); A2_RD16(F2, vb10, vb11, 1024); A2_MM4(3, F3, 1);
        A2_WL(4); A2_RD16(F3, vb10, vb11, 9216); A2_MM4(4, F0, 0);
        A2_WL(4); A2_RD16(F0, vb00, vb01, 1536); A2_MM4(4, F1, 1);
        A2_WL(4); A2_RD16(F1, vb00, vb01, 9728); A2_MM4(5, F2, 0);
        A2_WL(4); A2_RD16(F2, vb10, vb11, 1536); A2_MM4(5, F3, 1);
        A2_WL(4); A2_RD16(F3, vb10, vb11, 9728); A2_MM4(6, F0, 0);
        A2_WL(4); A2_MM4(6, F1, 1);
        A2_WL(2); A2_MM4(7, F2, 0);
        A2_WL(0); A2_MM4(7, F3, 1);
#undef A2_MM4
        A2_BARV();
      }
      const int zE = opaque0(); const int lanee = lane + zE, qe = (lane & 15) + zE, ge = (lane >> 4) + zE;
      float rl[4];
      rl[0] = __builtin_amdgcn_rcpf(XA0[128 + qe]); rl[1] = __builtin_amdgcn_rcpf(XA0[128 + 16 + qe]); rl[2] = __builtin_amdgcn_rcpf(XA1[128 + qe]); rl[3] = __builtin_amdgcn_rcpf(XA1[128 + 16 + qe]);
      if (pass == 0) {
        GAS v4u* sp = (GAS v4u*)stash + lanee;
#pragma unroll
        for (int cc = 0; cc < 8; ++cc)
#pragma unroll
          for (int jp = 0; jp < 2; ++jp) { const float c0 = -lam * rl[2 * jp], c1 = -lam * rl[2 * jp + 1];
            v4u tt; tt.x = cvtpk(oacc[cc][2 * jp][0] * c0, oacc[cc][2 * jp][1] * c0); tt.y = cvtpk(oacc[cc][2 * jp][2] * c0, oacc[cc][2 * jp][3] * c0);
            tt.z = cvtpk(oacc[cc][2 * jp + 1][0] * c1, oacc[cc][2 * jp + 1][1] * c1); tt.w = cvtpk(oacc[cc][2 * jp + 1][2] * c1, oacc[cc][2 * jp + 1][3] * c1);
            *sp = tt; sp += 64; asm volatile("" : "+v"(sp) :: "memory"); }
      } else {
        float sq[4] = {0.f, 0.f, 0.f, 0.f};
        v4u ro[4][4];
        const GAS v4u* sp = (const GAS v4u*)stash + lanee;
#pragma unroll
        for (int h = 0; h < 2; ++h) {
          v4u w[8];
#pragma unroll
          for (int i = 0; i < 8; ++i) { w[i] = *sp; sp += 64; asm volatile("" : "+v"(sp)); }
          asm volatile("" ::: "memory");
#pragma unroll
          for (int pr = 0; pr < 2; ++pr) {
            v2u wd[2][4];
#pragma unroll
            for (int e = 0; e < 2; ++e) { const int lc = 2 * pr + e, cc = 4 * h + lc;
#pragma unroll
              for (int jp = 0; jp < 2; ++jp) { const v4u q = w[2 * lc + jp]; const int qa = 2 * jp, qb2 = 2 * jp + 1;
                const float a0 = fmaf(oacc[cc][qa][0], rl[qa], bf_lo(q.x)), a1 = fmaf(oacc[cc][qa][1], rl[qa], bf_hi(q.x)), a2 = fmaf(oacc[cc][qa][2], rl[qa], bf_lo(q.y)), a3 = fmaf(oacc[cc][qa][3], rl[qa], bf_hi(q.y));
                const float b0 = fmaf(oacc[cc][qb2][0], rl[qb2], bf_lo(q.z)), b1 = fmaf(oacc[cc][qb2][1], rl[qb2], bf_hi(q.z)), b2 = fmaf(oacc[cc][qb2][2], rl[qb2], bf_lo(q.w)), b3 = fmaf(oacc[cc][qb2][3], rl[qb2], bf_hi(q.w));
                sq[qa] = fmaf(a0, a0, sq[qa]); sq[qa] = fmaf(a1, a1, sq[qa]); sq[qa] = fmaf(a2, a2, sq[qa]); sq[qa] = fmaf(a3, a3, sq[qa]);
                sq[qb2] = fmaf(b0, b0, sq[qb2]); sq[qb2] = fmaf(b1, b1, sq[qb2]); sq[qb2] = fmaf(b2, b2, sq[qb2]); sq[qb2] = fmaf(b3, b3, sq[qb2]);
                wd[e][qa].x = cvtpk(a0, a1); wd[e][qa].y = cvtpk(a2, a3); wd[e][qb2].x = cvtpk(b0, b1); wd[e][qb2].y = cvtpk(b2, b3); } }
#pragma unroll
            for (int qb = 0; qb < 4; ++qb) {
              const auto ax = __builtin_amdgcn_permlane16_swap(wd[0][qb].x, wd[1][qb].x, false, false), ay = __builtin_amdgcn_permlane16_swap(wd[0][qb].y, wd[1][qb].y, false, false);
              ro[2 * h + pr][qb] = (v4u){ax[0], ay[0], ax[1], ay[1]}; }
          }
          asm volatile("" ::: "memory");
        }
#pragma unroll
        for (int qb = 0; qb < 4; ++qb) { sq[qb] += __shfl_xor(sq[qb], 16); sq[qb] += __shfl_xor(sq[qb], 32); }
        { float* XS = (float*)(lds + X_OFF + bw * 1024) + 192;
          if (ge == 0) { XS[qe] = sq[0]; XS[16 + qe] = sq[1]; XS[32 + qe] = sq[2]; XS[48 + qe] = sq[3]; } }
        A2_BAR();
        float rs[4];
        { const float* XP = (const float*)(lds + X_OFF + (bw ^ 1) * 1024) + 192;
#pragma unroll
          for (int qb = 0; qb < 4; ++qb) rs[qb] = rsqrtf((sq[qb] + XP[16 * qb + qe]) * (1.f / VD) + SUBLN_EPS); }
        GAS bf16* rp = (GAS bf16*)Oc + (long)(64 * rh + qe) * DM + 128 * ch + 16 * (ge & 1) + 8 * (ge >> 1); asm volatile("" : "+v"(rp) :: "memory");
#define A2_RS(q, r) cvtpk(bf_lo(q) * (r), bf_hi(q) * (r))
#pragma unroll
        for (int P = 0; P < 4; ++P)
#pragma unroll
          for (int qb = 0; qb < 4; ++qb) { const v4u q = ro[P][qb]; v4u o; o.x = A2_RS(q.x, rs[qb]); o.y = A2_RS(q.y, rs[qb]); o.z = A2_RS(q.z, rs[qb]); o.w = A2_RS(q.w, rs[qb]);
            *(GAS v4u*)(rp + (long)(16 * qb) * DM + 32 * P) = o; }
#undef A2_RS
      }
#undef A2_DMAK
#undef A2_DMAV
#undef A2_BARV
#undef A2_K1
#undef A2_V1
#undef A2_RD16
#undef A2_WL
#undef A2_MM16
    }
  }
}
}

#define XB_TMO      128
#define XB_XCNT(j)  (256  + 64 * (j))
#define XB_XSUB(j)  (1280 + 64 * (j))
#define XB_XGEN(j)  (2304 + 64 * (j))
#define XB_TOP      3328
#define XB_TOPGEN   3392
#define XCD_BAR_WORDS 3456
#define XB_SPIN_CAP (1u << 20)

__device__ __forceinline__ unsigned xb_ld(unsigned* p)              { return __hip_atomic_load(p, __ATOMIC_RELAXED, __HIP_MEMORY_SCOPE_AGENT); }
__device__ __forceinline__ unsigned xb_add(unsigned* p, unsigned v) { return __hip_atomic_fetch_add(p, v, __ATOMIC_RELAXED, __HIP_MEMORY_SCOPE_AGENT); }
__device__ __forceinline__ unsigned xb_xcc_id() { return (unsigned)__builtin_amdgcn_s_getreg((3 << 11) | 20) & 0xFu; }
#define XB_SPIN(cond, bar) do { unsigned _sp = 0; while (cond) { __builtin_amdgcn_s_sleep(1); \
    if ((++_sp & 255u) == 0u) { if (xb_ld(&(bar)[XB_TMO])) break; if (_sp > XB_SPIN_CAP) { atomicAdd(&(bar)[XB_TMO], 1u); break; } } } } while (0)

struct XcdBarrier { unsigned* bar; unsigned x; volatile LAS unsigned* st; };

__device__ __forceinline__ XcdBarrier xcd_barrier_post(unsigned* bar, volatile LAS unsigned* st) {
    XcdBarrier b; b.bar = bar; b.x = xb_xcc_id(); b.st = st;
    if (threadIdx.x == 0) (void)xb_add(&bar[XB_XCNT(b.x)], 1u);
    return b;
}
__device__ __forceinline__ void xcd_barrier_complete(unsigned* bar, unsigned x, unsigned& nloc, unsigned& nx) {
    const unsigned G = gridDim.x * gridDim.y * gridDim.z;
    unsigned sum, cnt, mine, sp = 0u;
    for (;;) {
        sum = 0u; cnt = 0u; mine = 0u;
#pragma unroll
        for (unsigned j = 0; j < 16; ++j) { const unsigned c = xb_ld(&bar[XB_XCNT(j)]); sum += c; cnt += (c > 0u) ? 1u : 0u; mine = (j == x) ? c : mine; }
        if (sum == G) break;
        __builtin_amdgcn_s_sleep(1);
        if ((++sp & 255u) == 0u) { if (xb_ld(&bar[XB_TMO])) break; if (sp > XB_SPIN_CAP) { atomicAdd(&bar[XB_TMO], 1u); break; } }
    }
    nloc = mine > 0u ? mine : 1u; nx = cnt > 0u ? cnt : 1u;
}
__device__ __forceinline__ void xcd_barrier(const XcdBarrier& b) {
    asm volatile("s_waitcnt vmcnt(0)" ::: "memory");
    __syncthreads();
    if (threadIdx.x == 0) {
        unsigned* bar = b.bar;
        __builtin_amdgcn_s_waitcnt(0);
        unsigned nloc = b.st[0], nx = b.st[1];
        if (nloc == 0u) { xcd_barrier_complete(bar, b.x, nloc, nx); b.st[0] = nloc; b.st[1] = nx; }
        const unsigned old = xb_add(&bar[XB_XSUB(b.x)], 1u);
        const unsigned gen = old / nloc;
        if (old + 1u == (gen + 1u) * nloc) {
            __builtin_amdgcn_fence(__ATOMIC_RELEASE, "agent");
            asm volatile("s_waitcnt vmcnt(0)" ::: "memory");
            const unsigned og = xb_add(&bar[XB_TOP], 1u);
            const unsigned tg = og / nx;
            if (og + 1u == (tg + 1u) * nx) xb_add(&bar[XB_TOPGEN], 1u);
            else XB_SPIN(xb_ld(&bar[XB_TOPGEN]) == tg, bar);
            __builtin_amdgcn_fence(__ATOMIC_ACQUIRE, "agent");
            xb_add(&bar[XB_XGEN(b.x)], 1u);
            asm volatile("s_waitcnt vmcnt(0)" ::: "memory");
        } else {
            XB_SPIN(xb_ld(&bar[XB_XGEN(b.x)]) == gen, bar);
            __builtin_amdgcn_fence(__ATOMIC_ACQUIRE, "agent");
            asm volatile("s_waitcnt vmcnt(0)" ::: "memory");
        }
    }
    __syncthreads();
}

constexpr int NWAVES = 8;
constexpr int RING_OFF = 0, RING_BYTES = 131072;
constexpr int LDSCTL_OFF = 143360, MISC_OFF = LDSCTL_OFF + 320;
constexpr int ROPE_LDS_OFF = 147456;
constexpr int LDS_BYTES = 163840;

struct Args { const float* in[15]; float* out; unsigned char* ws; int ph_lo, ph_hi; };
static_assert(sizeof(Args) == 15 * 8 + 8 + 8 + 8, "Args has no padding");

template <int MODE>
__device__ __forceinline__ void p0_transpose_item(const float* __restrict__ W, int K, int N, bf16* __restrict__ WT, const float* __restrict__ gain, int gmask, float gscale, LAS float* scr, int item, int lane) {
    const int nblk = N / 32, kb = item / nblk, nb = item % nblk, k0 = 64 * kb, n0 = 32 * nb;
    const float* src = W + (size_t)(k0 + (lane >> 5)) * N + n0 + (lane & 31);
    float v[32];
#pragma unroll
    for (int i = 0; i < 32; ++i) v[i] = src[(size_t)(2 * i) * N];
    const int c = lane & 7;
    f32x4 g0 = {gscale, gscale, gscale, gscale}, g1 = g0;
    if (gain) { const int kg = (k0 + 8 * c) & gmask; g0 = *(const f32x4*)(gain + kg) * gscale; g1 = *(const f32x4*)(gain + kg + 4) * gscale; }
#pragma unroll
    for (int i = 0; i < 32; ++i) scr[(2 * i + (lane >> 5)) * 33 + (lane & 31)] = v[i];
    LDS_WAIT(); asm volatile("" ::: "memory");
    int d0 = n0;
    if (MODE == 1) { const int cc = n0 < DFF ? n0 : n0 - DFF; d0 = (cc >> 7) * 256 + (cc & 127) + (n0 < DFF ? 0 : 128); }
#pragma unroll
    for (int j = 0; j < 4; ++j) { const int n = (lane >> 3) + 8 * j; const LAS float* s = scr + (8 * c) * 33 + n;
        v4u o; o.x = cvt_pk_bf16(s[0 * 33] * g0[0], s[1 * 33] * g0[1]); o.y = cvt_pk_bf16(s[2 * 33] * g0[2], s[3 * 33] * g0[3]);
        o.z = cvt_pk_bf16(s[4 * 33] * g1[0], s[5 * 33] * g1[1]); o.w = cvt_pk_bf16(s[6 * 33] * g1[2], s[7 * 33] * g1[3]);
        *(v4u*)(WT + (size_t)(d0 + n) * K + k0 + 8 * c) = o; }
    LDS_WAIT(); asm volatile("" ::: "memory");
}

__global__ void __launch_bounds__(NWAVES * 64, 2) fwd_kernel(Args args) {
    extern __shared__ __attribute__((aligned(16))) unsigned char lds[];
    LAS unsigned char* ldsl = (LAS unsigned char*)lds;
    volatile LAS unsigned* MISC = (volatile LAS unsigned*)(ldsl + MISC_OFF);
    const int tid = threadIdx.x, lane = tid & 63, wave = __builtin_amdgcn_readfirstlane(tid >> 6);
    const int G = gridDim.x, bx = blockIdx.x;
    const int vcu = (G % 8 == 0) ? (bx % 8) * (G / 8) + bx / 8 : bx;
    const int gw = vcu * NWAVES + wave, NGW = G * NWAVES;
    unsigned char* ws = args.ws;
    gu32* ctl = (gu32*)(ws + WS_CTL);

    const float* x_p = args.in[0]; const float* x_s = args.in[1];
    const float* norm_mix = args.in[2]; const float* norm_ffn = args.in[3]; const float* norm_final = args.in[4];
    const float* w_qkv = args.in[5]; const float* w_o = args.in[6];
    const float* lq1 = args.in[7]; const float* lk1 = args.in[8]; const float* lq2 = args.in[9]; const float* lk2 = args.in[10];
    const float* subln = args.in[11]; const float* w_f = args.in[12]; const float* w_gu = args.in[13]; const float* w_dn = args.in[14];
    float* out = args.out;

    u64* ss0 = (u64*)(ws + WS_SS); u64* ss1 = ss0 + NTOK; u64* ss2 = ss1 + NTOK; u64* ss3 = ss2 + NTOK; u64* ss4 = ss3 + NTOK;
    float* rcos = (float*)(ws + WS_ROPE); float* rsin = rcos + SEQ_P * 16;
    bf16* Wc = (bf16*)(ws + WS_WC); bf16* D4096 = (bf16*)(ws + WS_D4096); bf16* D2048 = (bf16*)(ws + WS_D2048);
    bf16* Wqkv_t = (bf16*)(ws + WS_WQKV); bf16* Wo_t = (bf16*)(ws + WS_WO); bf16* Wf_t = (bf16*)(ws + WS_WF);
    bf16* Wgu_t0 = (bf16*)(ws + WS_WGU0); bf16* Wgu_t1 = (bf16*)(ws + WS_WGU1); bf16* Wd_t0 = (bf16*)(ws + WS_WD0); bf16* Wd_t1 = (bf16*)(ws + WS_WD1);
    bf16* XB = (bf16*)(ws + WS_XB); bf16* QKV = (bf16*)(ws + WS_QKV); bf16* HB = (bf16*)(ws + WS_HB);
    bf16* OB = (bf16*)(ws + WS_OB); bf16* YT = (bf16*)(ws + WS_YT); bf16* OC = (bf16*)(ws + WS_OC); bf16* FB = (bf16*)(ws + WS_F); bf16* XF = (bf16*)(ws + WS_XF); float* avec = (float*)(ws + WS_AVEC);

    for (int u = tid; u < (LDS_BYTES - LDSCTL_OFF) / 4; u += NWAVES * 64) ((LAS unsigned*)(ldsl + LDSCTL_OFF))[u] = 0u;
    __syncthreads();
#if MK_PER_PHASE
    XcdBarrier bar; bar.bar = (unsigned*)(ctl + CW_BAR); bar.x = 0; bar.st = nullptr;
#define GRID_BAR() do { } while (0)
#else
    XcdBarrier bar = xcd_barrier_post((unsigned*)(ctl + CW_BAR), MISC + 8);
#define GRID_BAR() xcd_barrier(bar)
#endif
    const int lo = args.ph_lo, hi = args.ph_hi;
#define IN(k) (lo <= (k) && (k) < hi)
#define BOTH(k) (IN(k) && IN((k) + 1))

    if (IN(0)) {
      {
        LAS float* scr = (LAS float*)(ldsl + RING_OFF + wave * 16384);
        constexpr int I_QKV = (DM / 64) * (NQKV / 32), I_O = (DM / 64) * (DM / 32), I_GU = (DM / 64) * (NGU / 32), I_D = (DFF / 64) * (DM / 32);
        constexpr int NITEMS = I_QKV + 2 * I_O + 2 * I_GU + 2 * I_D;
        for (int it = gw; it < NITEMS; it += NGW) {
            int r = it;
            if (r < I_QKV) { p0_transpose_item<0>(w_qkv, DM, NQKV, Wqkv_t, norm_mix, DM - 1, 1.f, scr, r, lane); continue; } r -= I_QKV;
            if (r < I_O) { p0_transpose_item<0>(w_o, DM, DM, Wo_t, subln, VD - 1, 1.f - LAMBDA_INIT, scr, r, lane); continue; } r -= I_O;
            if (r < I_O) { p0_transpose_item<0>(w_f, DM, DM, Wf_t, nullptr, 0, 1.f, scr, r, lane); continue; } r -= I_O;
            if (r < I_GU) { p0_transpose_item<1>(w_gu, DM, NGU, Wgu_t0, norm_ffn, DM - 1, 1.f, scr, r, lane); continue; } r -= I_GU;
            if (r < I_GU) { p0_transpose_item<1>(w_gu + (size_t)DM * NGU, DM, NGU, Wgu_t1, norm_ffn + DM, DM - 1, 1.f, scr, r, lane); continue; } r -= I_GU;
            if (r < I_D) { p0_transpose_item<0>(w_dn, DFF, DM, Wd_t0, nullptr, 0, 1.f, scr, r, lane); continue; } r -= I_D;
            p0_transpose_item<0>(w_dn + (size_t)DFF * DM, DFF, DM, Wd_t1, nullptr, 0, 1.f, scr, r, lane);
        }
        for (int row = gw; row < NTOK; row += NGW) {
            const float* src = row < NTOK_P ? x_p + (size_t)row * DM : x_s + (size_t)(row - NTOK_P) * DM;
            const f32x4* s4 = (const f32x4*)src + lane; v2u* d2 = (v2u*)(XB + (size_t)row * DM) + lane;
            float s = 0.f; f32x4 xv[16];
#pragma unroll
            for (int j = 0; j < 16; ++j) xv[j] = s4[64 * j];
#pragma unroll
            for (int j = 0; j < 16; ++j) { const f32x4 v = xv[j]; s += (v[0] * v[0] + v[1] * v[1]) + (v[2] * v[2] + v[3] * v[3]);
                v2u w; w.x = cvt_pk_bf16(v[0], v[1]); w.y = cvt_pk_bf16(v[2], v[3]); d2[64 * j] = w; }
            s = wave_sum(s);
            if (lane == 0) ss0[row] = ss_fix(s);
        }
        const int gt = gw * 64 + lane, NGT = NGW * 64;
        for (int i = gt; i < 4 * NTOK; i += NGT) ss1[i] = 0;
        for (int i = gt; i < SEQ_P * 16; i += NGT) { const int pos = i >> 4, f = i & 15;
            const float inv = powf(500000.f, -(float)(2 * f) / 32.f); const float ang = (float)pos * inv; rcos[i] = cosf(ang); rsin[i] = sinf(ang); }
        for (int i = gt; i < NGRP * 2 * GDIM * GDIM; i += NGT) { const int c = i & 511, j = (i >> 9) & 511, part = (i >> 18) & 1, g = i >> 19;
            const int mm = (j * c) & 511; const float a = (float)mm * (2.f / 512.f);
            const float v = (part ? sinpif(a) : cospif(a)) * 0.044194173824159216f * norm_mix[DM + g * GDIM + c];
            Wc[i] = (bf16)(cvt_pk_bf16(v, 0.f) & 0xffffu); }
        for (int i = gt; i < SEQ_P * SEQ_P / 2; i += NGT) {      const int kk = i & (SEQ_P - 1), n = i >> 12; const int part = kk >> 11, k = kk & (SEQ_P / 2 - 1);
            const int mm = (n * k) & (SEQ_P - 1); const float a = (float)mm * (2.f / SEQ_P);
            const float v = (part ? -sinpif(a) : cospif(a)) * 0.015625f;
            D4096[i] = (bf16)(cvt_pk_bf16(v, 0.f) & 0xffffu); }
        for (int i = gt; i < SEQ_S * SEQ_S / 2; i += NGT) { const int kk = i & (SEQ_S - 1), n = i >> 11; const int part = kk >> 10, k = kk & (SEQ_S / 2 - 1);
            const int mm = (n * k) & (SEQ_S - 1); const float a = (float)mm * (2.f / SEQ_S);
            const float v = (part ? -sinpif(a) : cospif(a)) * 0.022097086912079608f;
            D2048[i] = (bf16)(cvt_pk_bf16(v, 0.f) & 0xffffu); }
      }
        if (BOTH(0)) GRID_BAR();
    }

    if (IN(1)) {
        ProbPlain P{XB, Wqkv_t, DM, DM, DM}; pg8::StaticOrder S; S.init(NTOK / 256, NQKV / 256, G, bx);
        EpiQKV E{QKV, ss0, rcos, rsin, -1, {}, ldsl + ROPE_LDS_OFF};
        pg8::gemm_phase<ProbPlain, EpiQKV, pg8::StaticOrder, PG8_ALIGN, PG8_SP2>(ldsl + RING_OFF, P, S, E);
        if (BOTH(1)) GRID_BAR();
    }

    if (IN(2)) {
        const float s1 = wave_sum(lq1[lane] * lk1[lane] + lq1[lane + 64] * lk1[lane + 64]);
        const float s2 = wave_sum(lq2[lane] * lk2[lane] + lq2[lane + 64] * lk2[lane + 64]);
        const float lam = expf(s1) - expf(s2) + LAMBDA_INIT;
        unsigned* stash = (unsigned*)OB + ((size_t)vcu * 4 + (wave & 3)) * 4096;
        for (int i = 0;; ++i) {
            int idx = i * G + vcu; if (idx >= 4096) break;
            int kv0, q0, seq, h;
            if (idx < 2048) { const int qt = idx & 31, bh = idx >> 5; h = bh & 15; kv0 = (bh >> 4) * SEQ_P; q0 = qt * 128; seq = SEQ_P; }
            else { idx -= 2048; const int qt = idx & 15, bh = idx >> 4; h = bh & 15; kv0 = NTOK_P + (bh >> 4) * SEQ_S; q0 = qt * 128; seq = SEQ_S; }
            attn2::unit(QKV + (size_t)kv0 * NQKV + h * 256, q0, seq, OC + (size_t)(kv0 + q0) * DM + h * 256, lam, stash, (char*)lds + RING_OFF);
        }
        if (IN(2) && hi > 3) GRID_BAR();
    }

    if (IN(4)) {
        ProbPlain P{OC, Wo_t, DM, DM, DM}; pg8::StaticOrder S; S.init(NTOK / 256, DM / 256, G, bx);
        EpiRes E{XB, ss1};
        pg8::gemm_phase<ProbPlain, EpiRes, pg8::StaticOrder, PG8_ALIGN, PG8_SP2>(ldsl + RING_OFF, P, S, E);
        if (BOTH(4)) GRID_BAR();
    }
    if (IN(5)) {
        ProbPlain P{XB, Wgu_t0, DM, DM, DM}; pg8::StaticOrder S; S.init(NTOK / 256, NGU / 256, G, bx);
        EpiGateUp E{HB, ss1, -1, {}};
        pg8::gemm_phase<ProbPlain, EpiGateUp, pg8::StaticOrder, PG8_ALIGN, PG8_SP2>(ldsl + RING_OFF, P, S, E);
        if (BOTH(5)) GRID_BAR();
    }
    if (IN(6)) {
        ProbPlain P{HB, Wd_t0, DFF, DFF, DFF}; pg8::StaticOrder S; S.init(NTOK / 256, DM / 256, G, bx, WGM_DOWN);
        EpiRes E{XB, ss2};
        pg8::gemm_phase<ProbPlain, EpiRes, pg8::StaticOrder, PG8_ALIGN, PG8_SP2>(ldsl + RING_OFF, P, S, E);
        if (BOTH(6)) GRID_BAR();
    }
    if (IN(7)) {
        for (int t = gw; t < 16384; t += NGW) {
            int k, seq; size_t tok0;
            if (t < 8192) { k = t & 2047; seq = SEQ_P; tok0 = (size_t)(t >> 11) * SEQ_P; } else { const int t2 = t - 8192; k = t2 & 1023; seq = SEQ_S; tok0 = NTOK_P + (size_t)(t2 >> 10) * SEQ_S; }
            const size_t r1 = tok0 + k, r2 = tok0 + (k ? seq - k : 0);
            const float rs1 = ss_rstd(ss2[r1]), rs2 = k ? ss_rstd(ss2[r2]) : 0.f;
            const v2u* p1 = (const v2u*)(XB + r1 * DM) + lane; const v2u* p2 = (const v2u*)(XB + r2 * DM) + lane;
            v2u* qe = (v2u*)(XF + r1 * DM) + lane; v2u* qo = (v2u*)(XF + (r1 + seq / 2) * DM) + lane;
            v2u a[16], b[16];
#pragma unroll
            for (int j = 0; j < 16; ++j) { a[j] = p1[64 * j]; b[j] = p2[64 * j]; }
#pragma unroll
            for (int j = 0; j < 16; ++j) {
                const f32x4 x1 = (f32x4){bf_lo(a[j].x), bf_hi(a[j].x), bf_lo(a[j].y), bf_hi(a[j].y)} * rs1, x2 = (f32x4){bf_lo(b[j].x), bf_hi(b[j].x), bf_lo(b[j].y), bf_hi(b[j].y)} * rs2;
                const f32x4 e = x1 + x2; f32x4 o = x1 - x2; if (k == 0) o = (f32x4){0.f, 0.f, 0.f, 0.f};
                v2u we, wo; we.x = cvt_pk_bf16(e[0], e[1]); we.y = cvt_pk_bf16(e[2], e[3]); wo.x = cvt_pk_bf16(o[0], o[1]); wo.y = cvt_pk_bf16(o[2], o[3]);
                qe[64 * j] = we; qo[64 * j] = wo; }
        }
        for (int t = gw; t < 12 * NGRP * 8; t += NGW) {
            const int jc = t & 7, g = (t >> 3) & 7, bi = t >> 6;
            const int seq = bi < NB_P ? SEQ_P : SEQ_S; const size_t row = (bi < NB_P ? (size_t)bi * SEQ_P : NTOK_P + (size_t)(bi - NB_P) * SEQ_S) + seq / 2;
            const float rs = ss_rstd(ss2[row]) * (bi < NB_P ? 0.015625f : 0.022097086912079608f);
            const v4u xw = *((const v4u*)(XB + row * DM + g * GDIM) + lane);
            const f32x4 xa = (f32x4){bf_lo(xw.x), bf_hi(xw.x), bf_lo(xw.y), bf_hi(xw.y)} * rs, xb = (f32x4){bf_lo(xw.z), bf_hi(xw.z), bf_lo(xw.w), bf_hi(xw.w)} * rs;
            const bf16* wrow = Wc + ((size_t)g * 2 * 512 + jc * 64) * GDIM + 8 * lane;
            for (int jj = 0; jj < 64; ++jj) {
                const v4u w = *(const v4u*)(wrow + (size_t)jj * GDIM);
                float d = (bf_lo(w.x) * xa[0] + bf_hi(w.x) * xa[1]) + (bf_lo(w.y) * xa[2] + bf_hi(w.y) * xa[3]) + (bf_lo(w.z) * xb[0] + bf_hi(w.z) * xb[1]) + (bf_lo(w.w) * xb[2] + bf_hi(w.w) * xb[3]);
                d = wave_sum(d);
                if (lane == 0) avec[(size_t)bi * DM + g * GDIM + jc * 64 + jj] = d;
            }
        }
        if (BOTH(7)) GRID_BAR();
    }
    if (IN(8)) {
        { ProbChanDft P{Wc, XF, GDIM, GDIM, DM, SEQ_P, 0}; pg8::StaticOrder S; S.init(NB_P * NGRP * 2, SEQ_P / 256, G, bx);
          EpiBf16Plain E{YT, SEQ_P};
          pg8::gemm_phase<ProbChanDft, EpiBf16Plain, pg8::StaticOrder, PG8_ALIGN, PG8_SP2>(ldsl + RING_OFF, P, S, E); }
        { ProbChanDft P{Wc, XF, GDIM, GDIM, DM, SEQ_S, NTOK_P}; pg8::StaticOrder S; S.init(NB_S * NGRP * 2, SEQ_S / 256, G, bx);
          EpiBf16Plain E{YT + (size_t)NTOK_P * DM, SEQ_S};
          pg8::gemm_phase<ProbChanDft, EpiBf16Plain, pg8::StaticOrder, PG8_ALIGN, PG8_SP2>(ldsl + RING_OFF, P, S, E); }
        if (BOTH(8)) GRID_BAR();
    }
    bf16* Ebuf = (bf16*)(ws + WS_HB);
    if (IN(9)) {
        { ProbSeqDftH P{D4096, YT, SEQ_P / 2, SEQ_P, SEQ_P, SEQ_P / 512, 0}; pg8::StaticOrder S; S.init(NB_P * (SEQ_P / 512), DM / 256, G, bx);
          EpiSeqE E{Ebuf, avec, SEQ_P / 512};
          pg8::gemm_phase<ProbSeqDftH, EpiSeqE, pg8::StaticOrder, PG8_ALIGN, PG8_SP2>(ldsl + RING_OFF, P, S, E); }
        { ProbSeqDftH P{D2048, YT + (size_t)NTOK_P * DM, SEQ_S / 2, SEQ_S, SEQ_S, SEQ_S / 512, 0}; pg8::StaticOrder S; S.init(NB_S * (SEQ_S / 512), DM / 256, G, bx);
          EpiSeqE E{Ebuf + (size_t)(NTOK_P / 2) * DM, avec + (size_t)NB_P * DM, SEQ_S / 512};
          pg8::gemm_phase<ProbSeqDftH, EpiSeqE, pg8::StaticOrder, PG8_ALIGN, PG8_SP2>(ldsl + RING_OFF, P, S, E); }
        for (int r = gw; r < (NB_P + NB_S) * DM; r += NGW) {
            const bool pr = r < NB_P * DM; const int rr = pr ? r : r - NB_P * DM, b = rr >> 12, col = rr & (DM - 1), seq = pr ? SEQ_P : SEQ_S;
            const bf16* y = (pr ? YT : YT + (size_t)NTOK_P * DM) + ((size_t)b * DM + col) * seq;
            float sacc = 0.f;
            for (int k = lane * 8; k < seq / 2; k += 512) { const v4u q = *(const v4u*)(y + k);
                sacc += (bf_lo(q.x) - bf_hi(q.x)) + (bf_lo(q.y) - bf_hi(q.y)) + (bf_lo(q.z) - bf_hi(q.z)) + (bf_lo(q.w) - bf_hi(q.w)); }
            sacc = wave_sum(sacc);
            if (lane == 0) { const float v = sacc * (pr ? 0.015625f : 0.022097086912079608f) + avec[(size_t)(pr ? b : NB_P + b) * DM + col];
                bf16* o = FB + ((pr ? (size_t)b * SEQ_P : (size_t)NTOK_P + (size_t)b * SEQ_S) + seq / 2) * DM + col;
                *(unsigned short*)o = (unsigned short)(cvt_pk_bf16(v, 0.f) & 0xffffu); }
        }
        if (BOTH(9)) GRID_BAR();
    }
    if (IN(10)) {
        { ProbSeqDftH P{D4096, YT, SEQ_P / 2, SEQ_P, SEQ_P, SEQ_P / 512, SEQ_P / 2}; pg8::StaticOrder S; S.init(NB_P * (SEQ_P / 512), DM / 256, G, bx);
          EpiSeqO E{Ebuf, FB, SEQ_P / 512, SEQ_P};
          pg8::gemm_phase<ProbSeqDftH, EpiSeqO, pg8::StaticOrder, PG8_ALIGN, PG8_SP2>(ldsl + RING_OFF, P, S, E); }
        { ProbSeqDftH P{D2048, YT + (size_t)NTOK_P * DM, SEQ_S / 2, SEQ_S, SEQ_S, SEQ_S / 512, SEQ_S / 2}; pg8::StaticOrder S; S.init(NB_S * (SEQ_S / 512), DM / 256, G, bx);
          EpiSeqO E{Ebuf + (size_t)(NTOK_P / 2) * DM, FB + (size_t)NTOK_P * DM, SEQ_S / 512, SEQ_S};
          pg8::gemm_phase<ProbSeqDftH, EpiSeqO, pg8::StaticOrder, PG8_ALIGN, PG8_SP2>(ldsl + RING_OFF, P, S, E); }
        if (BOTH(10)) GRID_BAR();
    }
    if (IN(11)) {
        ProbPlain P{FB, Wf_t, DM, DM, DM}; pg8::StaticOrder S; S.init(NTOK / 256, DM / 256, G, bx);
        EpiRes E{XB, ss3};
        pg8::gemm_phase<ProbPlain, EpiRes, pg8::StaticOrder, PG8_ALIGN, PG8_SP2>(ldsl + RING_OFF, P, S, E);
        if (BOTH(11)) GRID_BAR();
    }
    if (IN(12)) {
        ProbPlain P{XB, Wgu_t1, DM, DM, DM}; pg8::StaticOrder S; S.init(NTOK / 256, NGU / 256, G, bx);
        EpiGateUp E{HB, ss3, -1, {}};
        pg8::gemm_phase<ProbPlain, EpiGateUp, pg8::StaticOrder, PG8_ALIGN, PG8_SP2>(ldsl + RING_OFF, P, S, E);
        if (BOTH(12)) GRID_BAR();
    }
    if (IN(13)) {
        ProbPlain P{HB, Wd_t1, DFF, DFF, DFF}; pg8::StaticOrder S; S.init(NTOK / 256, DM / 256, G, bx, WGM_DOWN);
        EpiRes E{XB, ss4};
        pg8::gemm_phase<ProbPlain, EpiRes, pg8::StaticOrder, PG8_ALIGN, PG8_SP2>(ldsl + RING_OFF, P, S, E);
        if (BOTH(13)) GRID_BAR();
    }
    if (IN(14)) {
        for (int row = gw; row < NTOK; row += NGW) {
            const float rs = ss_rstd(ss4[row]);
            f32x4* o4 = (f32x4*)(out + (size_t)row * DM) + lane; const f32x4* g4 = (const f32x4*)norm_final + lane; const v2u* x2 = (const v2u*)(XB + (size_t)row * DM) + lane;
            v2u xv[16];
#pragma unroll
            for (int j = 0; j < 16; ++j) xv[j] = x2[64 * j];
#pragma unroll
            for (int j = 0; j < 16; ++j) o4[64 * j] = (f32x4){bf_lo(xv[j].x), bf_hi(xv[j].x), bf_lo(xv[j].y), bf_hi(xv[j].y)} * rs * g4[64 * j];
        }
    }
#undef IN
#undef BOTH
#undef GRID_BAR
}

extern "C" void kernel_launch(void* const* d_in, const int* in_sizes, int n_in, void* d_out, int out_size, void* d_ws, size_t ws_size, hipStream_t stream) {
    static int grid = 0;
    if (grid == 0) {
        if (n_in != 15 || in_sizes[0] != NTOK_P * DM || in_sizes[1] != (NTOK - NTOK_P) * DM || out_size != NTOK * DM || ws_size < WS_END) {
            fprintf(stderr, "kernel_launch: shape mismatch (n_in %d, in0 %d, in1 %d, out %d, ws %zu; need ws >= %zu); nothing launched\n", n_in, n_in > 0 ? in_sizes[0] : -1, n_in > 1 ? in_sizes[1] : -1, out_size, ws_size, (size_t)WS_END); grid = -1; return; }
        int dev = 0, cus = 0, per_cu = 0;
        if (hipGetDevice(&dev) != hipSuccess || hipDeviceGetAttribute(&cus, hipDeviceAttributeMultiprocessorCount, dev) != hipSuccess) { fprintf(stderr, "kernel_launch: device query failed\n"); grid = -1; return; }
        if (hipFuncSetAttribute((const void*)fwd_kernel, hipFuncAttributeMaxDynamicSharedMemorySize, LDS_BYTES) != hipSuccess) { fprintf(stderr, "kernel_launch: hipFuncSetAttribute failed\n"); grid = -1; return; }
        if (hipOccupancyMaxActiveBlocksPerMultiprocessor(&per_cu, (const void*)fwd_kernel, NWAVES * 64, LDS_BYTES) != hipSuccess || per_cu < 1)
            fprintf(stderr, "kernel_launch: note: occupancy query reports %d workgroups per CU\n", per_cu);
        (void)hipGetLastError();
        grid = cus;
    }
    if (grid < 0) return;
    if (hipMemsetAsync((char*)d_ws + WS_CTL, 0, CTL_ZERO_BYTES, stream) != hipSuccess) { fprintf(stderr, "kernel_launch: memset failed\n"); return; }
    Args a{};
    for (int i = 0; i < 15; ++i) a.in[i] = (const float*)d_in[i];
    a.out = (float*)d_out; a.ws = (unsigned char*)d_ws;
#if MK_PER_PHASE
    for (int p = 0; p < N_PHASES; ++p) { a.ph_lo = p; a.ph_hi = p + 1; hipLaunchKernelGGL(fwd_kernel, dim3(grid), dim3(NWAVES * 64), LDS_BYTES, stream, a); }
#else
    a.ph_lo = 0; a.ph_hi = N_PHASES;
    hipLaunchKernelGGL(fwd_kernel, dim3(grid), dim3(NWAVES * 64), LDS_BYTES, stream, a);
#endif
    const hipError_t le = hipPeekAtLastError();
    if (le != hipSuccess) fprintf(stderr, "kernel_launch: launch failed: %s\n", hipGetErrorName(le));
}
```

```cpp
#include <hip/hip_runtime.h>
#include <cstdio>
#include <cstdint>

#ifndef MK_PER_PHASE
#define MK_PER_PHASE 0
#endif

constexpr int DM = 4096, NTOK = 32768, NTOK_P = 16384, SEQ_P = 4096, SEQ_S = 2048, NB_P = 4, NB_S = 8;
constexpr int DFF = 11008, NQKV = 3 * DM, NGU = 2 * DFF;
constexpr int NH = 16, HD = 128, VD = 256, NGRP = 8, GDIM = 512;
constexpr float RMS_EPS = 1e-6f, SUBLN_EPS = 1e-5f, LAMBDA_INIT = 0.2f;
constexpr int N_PHASES = 15;
constexpr float QK_LOG2_SCALE = 0.088388347648318440f * 1.4426950408889634f;
#ifndef PG8_SP2
#define PG8_SP2 true
#endif
#ifndef WGM_DOWN
#define WGM_DOWN 4
#endif
#ifndef PG8_ALIGN
#define PG8_ALIGN true
#endif

constexpr size_t MiB = 1u << 20;
constexpr size_t WS_CTL = 0, CTL_ZERO_BYTES = 5 * MiB / 2;
constexpr size_t WS_SS = 1 * MiB;
constexpr size_t WS_ROPE = 3 * MiB;
constexpr size_t WS_AVEC = 7 * MiB / 2;
constexpr size_t WS_WC = 4 * MiB;
constexpr size_t WS_D4096 = 12 * MiB;
constexpr size_t WS_D2048 = 76 * MiB;
constexpr size_t WS_WQKV = 92 * MiB, WS_WO = 188 * MiB, WS_WF = 220 * MiB, WS_WGU0 = 252 * MiB, WS_WGU1 = 424 * MiB, WS_WD0 = 596 * MiB, WS_WD1 = 682 * MiB;
constexpr size_t WS_XB = 768 * MiB;
constexpr size_t WS_QKV = 1024 * MiB;
constexpr size_t WS_HB = WS_QKV;
constexpr size_t WS_OB = 1792 * MiB;
constexpr size_t WS_YT = WS_OB;
constexpr size_t WS_OC = 2304 * MiB;
constexpr size_t WS_F = WS_OC;
constexpr size_t WS_XF = WS_OC;
constexpr size_t WS_END = 2560 * MiB;
constexpr int CW_BAR = 4096;

#define GAS __attribute__((address_space(1)))
#define LAS __attribute__((address_space(3)))
typedef unsigned short bf16;
typedef unsigned v4u __attribute__((ext_vector_type(4)));
typedef unsigned v2u __attribute__((ext_vector_type(2)));
typedef float f32x4 __attribute__((ext_vector_type(4)));
typedef short bf16x8 __attribute__((ext_vector_type(8)));
typedef GAS unsigned gu32;
#define RLX_AGENT __ATOMIC_RELAXED, __HIP_MEMORY_SCOPE_AGENT
#define LDS_WAIT() asm volatile("s_waitcnt lgkmcnt(0)" ::: "memory")
#define VM_WAIT() asm volatile("s_waitcnt vmcnt(0)" ::: "memory")

__device__ __forceinline__ unsigned cvt_pk_bf16(float lo, float hi) { unsigned r; asm volatile("v_cvt_pk_bf16_f32 %0, %1, %2" : "=v"(r) : "v"(lo), "v"(hi)); return r; }
__device__ __forceinline__ float bf_lo(unsigned w) { return __uint_as_float(w << 16); }
__device__ __forceinline__ float bf_hi(unsigned w) { return __uint_as_float(w & 0xffff0000u); }
typedef unsigned long long u64;
constexpr float SS_SCALE = 16777216.f;
__device__ __forceinline__ u64 ss_fix(float s) { return (u64)(s * SS_SCALE); }
__device__ __forceinline__ float ss_rstd(u64 q) { return rsqrtf((float)q * (1.f / (SS_SCALE * DM)) + RMS_EPS); }
__device__ __forceinline__ float wave_sum(float v) {
#pragma unroll
    for (int o = 1; o < 64; o <<= 1) v += __shfl_xor(v, o);
    return v;
}

namespace pg8 {
#define PG8_LAS __attribute__((address_space(3)))
typedef unsigned short bf16_t;
typedef unsigned u32x4 __attribute__((ext_vector_type(4)));
constexpr int BM = 256, BK = 64, HALF = 128, HTB = HALF * BK * 2, STAGE_BYTES = 8 * HTB, NXCD = 8, WGM = 8;

__host__ __device__ __forceinline__ int lds_byte(int r, int c) { const int st = (r >> 4) * 2 + (c >> 5), rr = r & 15, cc = c & 31, ob = rr * 64 + cc * 2; return st * 1024 + (ob ^ (((ob >> 9) & 1) << 5)); }
__host__ __device__ __forceinline__ void stage_rc(int b, int& R, int& C) { const int st = b / 1024, sb = b % 1024, swz = sb ^ (((sb >> 9) & 1) << 5); R = (st >> 1) * 16 + swz / 64; C = (st & 1) * 32 + (swz % 64) / 2; }
__host__ __device__ __forceinline__ int perm32(int rho) { const int n = rho >> 4, i = rho & 15; return 8 * (i >> 2) + 4 * n + (i & 3); }

struct Unit { int pm, pn; };

struct StaticOrder {
    int nM, nN, nwg, G, c, wgm;
    __host__ __device__ void init(int nM_, int nN_, int G_, int c_, int wgm_ = WGM) { nM = nM_; nN = nN_; nwg = nM * nN; G = G_; c = c_; wgm = wgm_; }
    __host__ __device__ bool next(int i, Unit& u) const {
        const long L = (long)i * G + c; if (L >= nwg) return false;
        int wgid = (int)L; { const int q = nwg / NXCD, r = nwg % NXCD, xcd = wgid % NXCD, off = wgid / NXCD; wgid = (xcd < r ? xcd * (q + 1) : r * (q + 1) + (xcd - r) * q) + off; }
        const int nig = wgm * nN, gid = wgid / nig, fm = gid * wgm, gsz = (nM - fm) < wgm ? (nM - fm) : wgm;
        u.pm = fm + ((wgid % nig) % gsz); u.pn = (wgid % nig) / gsz; return true;
    }
};

template <class Prob, class Epi, class Sched, bool ALIGN_EPI, bool SP2>
__device__ __forceinline__ void gemm_phase(PG8_LAS unsigned char* lds, const Prob& P, const Sched& S, const Epi& E) {
    const int tid = threadIdx.x, wid = __builtin_amdgcn_readfirstlane(tid >> 6), lane = tid & 63, wr = wid >> 2, wc = wid & 3, fr = lane & 15, fq = lane >> 4;
    const int K = P.K, nt = K / BK, lda = P.lda, ldb = P.ldb;
    unsigned voffA[2], voffB[2];
#pragma unroll
    for (int i = 0; i < 2; ++i) { int R, C; stage_rc(tid * 16 + i * 8192, R, C); const int Rb = Epi::PERM ? ((R & ~31) + perm32(R & 31)) : R;
        voffA[i] = (unsigned)(R * lda + C) * 2u; voffB[i] = (unsigned)(Rb * ldb + C) * 2u; }
    const size_t kstep = (size_t)(BK * 2);
    const size_t Kb = (size_t)nt * kstep, rotb = (size_t)((((int)blockIdx.x & 7) * (nt >> 3)) & ~1) * kstep;
#define PG8_KOFF(t) ({ size_t x_ = (size_t)(t) * kstep + rotb; x_ >= Kb ? x_ - Kb : x_; })
    const size_t hA = (size_t)HALF * lda * 2, hB = (size_t)HALF * ldb * 2;
    const unsigned ldsw = (unsigned)wid * 1024u;
    const unsigned ldsb = (unsigned)(uintptr_t)lds + ldsw;
    const int aoff = lds_byte(wr * 64 + fr, fq * 8), boff = lds_byte(wc * 32 + fr, fq * 8);
#define PG8_SA(b, h) (((b) * 2 + (h)) * HTB)
#define PG8_SB(b, h) ((4 + (b) * 2 + (h)) * HTB)
#define PG8_STAGE(bufoff, gbase, voff) do { _Pragma("unroll") for (int _i = 0; _i < 2; ++_i) \
        asm volatile("s_mov_b32 m0, %2\n\ts_nop 0\n\tglobal_load_lds_dwordx4 %0, %1" :: "v"((voff)[_i]), "s"((const char*)(gbase)), "s"(ldsb + (unsigned)((bufoff) + _i * 8192)) : "memory", "m0"); } while (0)
#define PG8_LDA(dst, b, h) do { _Pragma("unroll") for (int m = 0; m < 4; ++m) _Pragma("unroll") for (int k = 0; k < 2; ++k) dst[m][k] = *(const PG8_LAS bf16x8*)(lds + PG8_SA(b, h) + aoff + m * 2048 + k * 1024); } while (0)
#define PG8_LDB(dst, b, h) do { _Pragma("unroll") for (int n = 0; n < 2; ++n) _Pragma("unroll") for (int k = 0; k < 2; ++k) dst[n][k] = *(const PG8_LAS bf16x8*)(lds + PG8_SB(b, h) + boff + n * 2048 + k * 1024); } while (0)
#define PG8_MMA(ai, bj, At, Bt) do { __builtin_amdgcn_s_setprio(1); _Pragma("unroll") for (int m = 0; m < 4; ++m) _Pragma("unroll") for (int n = 0; n < 2; ++n) _Pragma("unroll") for (int k = 0; k < 2; ++k) \
        acc[ai][bj][m][n] = __builtin_amdgcn_mfma_f32_16x16x32_bf16(Bt[n][k], At[m][k], acc[ai][bj][m][n], 0, 0, 0); __builtin_amdgcn_s_setprio(0); } while (0)
#define PG8_WAIT_V(n) asm volatile("s_waitcnt vmcnt(" #n ")" ::: "memory")
#define PG8_WAIT_L(n) asm volatile("s_waitcnt lgkmcnt(" #n ")" ::: "memory")
#define PG8_BAR __builtin_amdgcn_s_barrier()
#define PG8_SCHED __builtin_amdgcn_sched_barrier(0)
    Unit cur, nxt; int ui = 0;
    if (!S.next(0, cur)) return;
    f32x4 acc[2][2][4][2];
#pragma unroll
    for (int a = 0; a < 2; ++a)
#pragma unroll
        for (int b = 0; b < 2; ++b)
#pragma unroll
            for (int m = 0; m < 4; ++m)
#pragma unroll
                for (int n = 0; n < 2; ++n) acc[a][b][m][n] = (f32x4){0.f, 0.f, 0.f, 0.f};
    bf16x8 At[4][2], B0[2][2], B1[2][2];
    const char* cA = P.a_ptr(cur); const char* cB = P.b_ptr(cur);
    if constexpr (SP2) {
        const char* cA0 = cA + rotb; const char* cB0 = cB + rotb;
        PG8_STAGE(PG8_SB(0, 0), cB0, voffB); PG8_STAGE(PG8_SB(0, 1), cB0 + hB, voffB); PG8_STAGE(PG8_SA(0, 0), cA0, voffA); PG8_STAGE(PG8_SA(0, 1), cA0 + hA, voffA);
        if (wr == 1) PG8_BAR;
        PG8_WAIT_V(2); PG8_BAR;
        PG8_STAGE(PG8_SB(1, 0), cB0 + kstep, voffB); PG8_STAGE(PG8_SA(1, 0), cA0 + kstep, voffA); PG8_STAGE(PG8_SB(1, 1), cB0 + hB + kstep, voffB);
        PG8_WAIT_V(6); PG8_BAR;
    } else {
        PG8_STAGE(PG8_SB(0, 0), cB, voffB); PG8_STAGE(PG8_SA(0, 0), cA, voffA); PG8_STAGE(PG8_SB(0, 1), cB + hB, voffB); PG8_STAGE(PG8_SA(0, 1), cA + hA, voffA);
        if (wr == 1) PG8_BAR;
        PG8_WAIT_V(4); PG8_BAR;
        PG8_STAGE(PG8_SB(1, 0), cB + kstep, voffB); PG8_STAGE(PG8_SA(1, 0), cA + kstep, voffA); PG8_STAGE(PG8_SB(1, 1), cB + hB + kstep, voffB);
        PG8_WAIT_V(6); PG8_BAR;
    }
    for (;;) {
        const bool has_next = S.next(ui + 1, nxt);
        const char* nA = has_next ? P.a_ptr(nxt) : cA; const char* nB = has_next ? P.b_ptr(nxt) : cB;
        for (int t = 0; t < nt; t += 2) {
            const bool last = (t == nt - 2);
            const char* a1 = cA + PG8_KOFF(t) + kstep;
            const size_t ko2 = PG8_KOFF(t + 2);
            const char* a2 = last ? nA + rotb : cA + ko2; const char* b2 = last ? nB + rotb : cB + ko2;
            const char* a3 = a2 + kstep; const char* b3 = b2 + kstep;
            if constexpr (SP2) {
            PG8_LDB(B0, 0, 0); PG8_LDB(B1, 0, 1); PG8_SCHED; PG8_LDA(At, 0, 0); PG8_STAGE(PG8_SA(1, 1), a1 + hA, voffA);
            PG8_WAIT_V(8); PG8_WAIT_L(0); PG8_BAR; PG8_MMA(0, 0, At, B0); PG8_MMA(0, 1, At, B1); PG8_BAR; PG8_SCHED;
            PG8_LDA(At, 0, 1); PG8_STAGE(PG8_SB(0, 0), b2, voffB); PG8_STAGE(PG8_SB(0, 1), b2 + hB, voffB); PG8_STAGE(PG8_SA(0, 0), a2, voffA);
            PG8_WAIT_V(8); PG8_WAIT_L(0); PG8_BAR; PG8_MMA(1, 0, At, B0); PG8_MMA(1, 1, At, B1); PG8_BAR; PG8_SCHED;
            PG8_LDB(B0, 1, 0); PG8_LDB(B1, 1, 1); PG8_SCHED; PG8_LDA(At, 1, 0); PG8_STAGE(PG8_SA(0, 1), a2 + hA, voffA);
            PG8_WAIT_V(8); PG8_WAIT_L(0); PG8_BAR; PG8_MMA(0, 0, At, B0); PG8_MMA(0, 1, At, B1); PG8_BAR; PG8_SCHED;
            PG8_LDA(At, 1, 1); PG8_STAGE(PG8_SB(1, 0), b3, voffB); PG8_STAGE(PG8_SB(1, 1), b3 + hB, voffB); PG8_STAGE(PG8_SA(1, 0), a3, voffA);
            PG8_WAIT_V(8); PG8_WAIT_L(0); PG8_BAR; PG8_MMA(1, 0, At, B0); PG8_MMA(1, 1, At, B1); PG8_BAR; PG8_SCHED;
            } else {
            PG8_LDB(B0, 0, 0); PG8_SCHED; PG8_LDA(At, 0, 0); PG8_STAGE(PG8_SA(1, 1), a1 + hA, voffA);
            PG8_WAIT_L(8); PG8_BAR; PG8_WAIT_L(0); PG8_MMA(0, 0, At, B0); PG8_BAR; PG8_SCHED;
            PG8_LDB(B1, 0, 1); PG8_STAGE(PG8_SB(0, 0), b2, voffB);
            PG8_BAR; PG8_WAIT_L(0); PG8_MMA(0, 1, At, B1); PG8_BAR;
            PG8_LDA(At, 0, 1); PG8_STAGE(PG8_SA(0, 0), a2, voffA);
            PG8_BAR; PG8_WAIT_L(0); PG8_MMA(1, 0, At, B0); PG8_BAR; PG8_SCHED;
            PG8_STAGE(PG8_SB(0, 1), b2 + hB, voffB);
            PG8_WAIT_V(6); PG8_BAR; PG8_MMA(1, 1, At, B1); PG8_BAR;
            PG8_LDB(B0, 1, 0); PG8_SCHED; PG8_LDA(At, 1, 0); PG8_STAGE(PG8_SA(0, 1), a2 + hA, voffA);
            PG8_WAIT_L(8); PG8_BAR; PG8_WAIT_L(0); PG8_MMA(0, 0, At, B0); PG8_BAR; PG8_SCHED;
            PG8_LDB(B1, 1, 1); PG8_STAGE(PG8_SB(1, 0), b3, voffB);
            PG8_BAR; PG8_WAIT_L(0); PG8_MMA(0, 1, At, B1); PG8_BAR;
            PG8_LDA(At, 1, 1); PG8_STAGE(PG8_SA(1, 0), a3, voffA);
            PG8_BAR; PG8_WAIT_L(0); PG8_MMA(1, 0, At, B0); PG8_BAR; PG8_SCHED;
            PG8_STAGE(PG8_SB(1, 1), b3 + hB, voffB);
            PG8_WAIT_V(6); PG8_BAR; PG8_MMA(1, 1, At, B1); PG8_BAR;
            }
        }
        if constexpr (ALIGN_EPI) { if (wr == 0) PG8_BAR; }
        E(acc, cur, wr, wc, fr, fq);
        if (!has_next) break;
#pragma unroll
        for (int a = 0; a < 2; ++a)
#pragma unroll
            for (int b = 0; b < 2; ++b)
#pragma unroll
                for (int m = 0; m < 4; ++m)
#pragma unroll
                    for (int n = 0; n < 2; ++n) acc[a][b][m][n] = (f32x4){0.f, 0.f, 0.f, 0.f};
        cur = nxt; cA = nA; cB = nB; ++ui;
        if constexpr (ALIGN_EPI) { if (wr == 1) PG8_BAR; }
    }
    PG8_WAIT_V(0);
    if constexpr (!ALIGN_EPI) { if (wr == 0) PG8_BAR; }
    PG8_BAR;
#undef PG8_SA
#undef PG8_SB
#undef PG8_STAGE
#undef PG8_LDA
#undef PG8_LDB
#undef PG8_MMA
#undef PG8_WAIT_V
#undef PG8_WAIT_L
#undef PG8_BAR
#undef PG8_SCHED
}
}

using pg8::Unit;
#define PG8_LAS_T __attribute__((address_space(3)))

struct ProbPlain {
    const bf16* A; const bf16* Bt; int K, lda, ldb;
    __device__ __forceinline__ const char* a_ptr(const Unit& u) const { return (const char*)(A + (size_t)u.pm * 256 * lda); }
    __device__ __forceinline__ const char* b_ptr(const Unit& u) const { return (const char*)(Bt + (size_t)u.pn * 256 * ldb); }
};
struct ProbChanDft {
    const bf16* Wc; const bf16* XF; int K, lda, ldb; int seq; size_t tok0;
    __device__ __forceinline__ const char* a_ptr(const Unit& u) const { const int z = u.pm >> 1, pmi = u.pm & 1, g = z & 7; const int part = (u.pn * 512 >= seq) ? 1 : 0;
        return (const char*)(Wc + (((size_t)g * 2 + part) * 512 + pmi * 256) * GDIM); }
    __device__ __forceinline__ const char* b_ptr(const Unit& u) const { const int z = u.pm >> 1, g = z & 7, b = z >> 3; return (const char*)(XF + (tok0 + (size_t)b * seq + (size_t)u.pn * 256) * DM + g * GDIM); }
};
struct ProbSeqDft {
    const bf16* Dm; const bf16* YT; int K, lda, ldb; int tps;
    __device__ __forceinline__ const char* a_ptr(const Unit& u) const { const int pmi = u.pm % tps; return (const char*)(Dm + (size_t)pmi * 256 * lda); }
    __device__ __forceinline__ const char* b_ptr(const Unit& u) const { const int b = u.pm / tps; return (const char*)(YT + (size_t)b * DM * ldb + (size_t)u.pn * 256 * ldb); }
};

struct EpiQKV {
    static constexpr bool PERM = true;
    bf16* O; const u64* ss; const float* rcos; const float* rsin; mutable int cpm; mutable float crs[2][4];
    PG8_LAS_T unsigned char* ropel;
    __device__ __forceinline__ void operator()(const f32x4 (&acc)[2][2][4][2], const Unit& u, int wr, int wc, int fr, int fq) const {
        const int row0 = u.pm * 256 + wr * 64 + fr, col0 = u.pn * 256 + wc * 32 + 8 * fq;
        const bool rope = (u.pn < 32) && (wc == 0);
        const float sgn = fq < 2 ? -1.f : 1.f;
        const float qs = u.pn < DM / 256 ? QK_LOG2_SCALE : 1.f;
        if (u.pm != cpm) {
            cpm = u.pm; u64 sq[2][4];
#pragma unroll
            for (int ai = 0; ai < 2; ++ai)
#pragma unroll
                for (int m = 0; m < 4; ++m) sq[ai][m] = ss[row0 + ai * 128 + m * 16];
#pragma unroll
            for (int ai = 0; ai < 2; ++ai)
#pragma unroll
                for (int m = 0; m < 4; ++m) crs[ai][m] = ss_rstd(sq[ai][m]);
            { const int tid = threadIdx.x, r = tid >> 1, part = tid & 1, grow = u.pm * 256 + r; const int pos = grow < NTOK_P ? (grow & (SEQ_P - 1)) : (grow & (SEQ_S - 1));
              const f32x4* src = (const f32x4*)((part ? rsin : rcos) + pos * 16);
              const f32x4 t0 = src[0], t1 = src[1], t2 = src[2], t3 = src[3];
              typedef _Float16 h2 __attribute__((ext_vector_type(2)));
#define QKV_H2(a, b) ({ h2 hh = {(_Float16)(a), (_Float16)(b)}; *(unsigned*)&hh; })
              pg8::u32x4 w0 = {QKV_H2(t0[0], t0[1]), QKV_H2(t0[2], t0[3]), QKV_H2(t1[0], t1[1]), QKV_H2(t1[2], t1[3])}, w1 = {QKV_H2(t2[0], t2[1]), QKV_H2(t2[2], t2[3]), QKV_H2(t3[0], t3[1]), QKV_H2(t3[2], t3[3])};
#undef QKV_H2
              *(PG8_LAS_T pg8::u32x4*)(ropel + r * 64 + part * 32) = w0; *(PG8_LAS_T pg8::u32x4*)(ropel + r * 64 + part * 32 + 16) = w1; }
            asm volatile("s_waitcnt lgkmcnt(0)" ::: "memory"); __builtin_amdgcn_s_barrier(); asm volatile("" ::: "memory");
        }
#pragma unroll
        for (int am = 0; am < 4; ++am) { const int ai = am >> 1;
            f32x4 c0[4], c1[4], s0[4], s1[4];
            if (rope) {
#pragma unroll
                for (int m = 2 * (am & 1); m < 2 * (am & 1) + 2; ++m) { const int lr = wr * 64 + fr + ai * 128 + m * 16;
                    typedef _Float16 h8 __attribute__((ext_vector_type(8)));
                    const h8 hc = *(const PG8_LAS_T h8*)(ropel + lr * 64 + (fq & 1) * 16), hs = *(const PG8_LAS_T h8*)(ropel + lr * 64 + 32 + (fq & 1) * 16);
                    c0[m] = (f32x4){(float)hc[0], (float)hc[1], (float)hc[2], (float)hc[3]}; c1[m] = (f32x4){(float)hc[4], (float)hc[5], (float)hc[6], (float)hc[7]};
                    s0[m] = (f32x4){(float)hs[0], (float)hs[1], (float)hs[2], (float)hs[3]}; s1[m] = (f32x4){(float)hs[4], (float)hs[5], (float)hs[6], (float)hs[7]}; }
            }
#pragma unroll
            for (int m = 2 * (am & 1); m < 2 * (am & 1) + 2; ++m) {
                const int row = row0 + ai * 128 + m * 16;
                const float rs = crs[ai][m] * qs;
                bf16* rowp = O + (size_t)row * NQKV + col0;
#pragma unroll
                for (int bj = 0; bj < 2; ++bj) {
                    f32x4 v0 = acc[ai][bj][m][0] * rs, v1 = acc[ai][bj][m][1] * rs;
                    if (rope) {
                        f32x4 p0, p1;
#pragma unroll
                        for (int j = 0; j < 4; ++j) { p0[j] = __shfl_xor(v0[j], 32); p1[j] = __shfl_xor(v1[j], 32); }
                        v0 = v0 * c0[m] + p0 * (s0[m] * sgn); v1 = v1 * c1[m] + p1 * (s1[m] * sgn);
                    }
                    pg8::u32x4 w; w.x = cvt_pk_bf16(v0[0], v0[1]); w.y = cvt_pk_bf16(v0[2], v0[3]); w.z = cvt_pk_bf16(v1[0], v1[1]); w.w = cvt_pk_bf16(v1[2], v1[3]);
                    *(pg8::u32x4*)(rowp + bj * 128) = w;
                }
            }
        }
    }
};

struct EpiRes {
    static constexpr bool PERM = true;
    bf16* xb; u64* ss;
    __device__ __forceinline__ void operator()(const f32x4 (&acc)[2][2][4][2], const Unit& u, int wr, int wc, int fr, int fq) const {
        const int row0 = u.pm * 256 + wr * 64 + fr, col0 = u.pn * 256 + wc * 32 + 8 * fq;
        bf16* base = xb + (size_t)row0 * DM + col0;
        pg8::u32x4 r[2][4][2];
#pragma unroll
        for (int ai = 0; ai < 2; ++ai)
#pragma unroll
            for (int m = 0; m < 4; ++m)
#pragma unroll
                for (int bj = 0; bj < 2; ++bj) r[ai][m][bj] = *(const pg8::u32x4*)(base + (size_t)(ai * 128 + m * 16) * DM + bj * 128);
#pragma unroll
        for (int ai = 0; ai < 2; ++ai)
#pragma unroll
            for (int m = 0; m < 4; ++m) {
                const int row = row0 + ai * 128 + m * 16; bf16* rowp = base + (size_t)(ai * 128 + m * 16) * DM;
                float s = 0.f;
#pragma unroll
                for (int bj = 0; bj < 2; ++bj) {
                    const pg8::u32x4 q = r[ai][m][bj];
                    const f32x4 v0 = acc[ai][bj][m][0] + (f32x4){bf_lo(q.x), bf_hi(q.x), bf_lo(q.y), bf_hi(q.y)}, v1 = acc[ai][bj][m][1] + (f32x4){bf_lo(q.z), bf_hi(q.z), bf_lo(q.w), bf_hi(q.w)};
                    pg8::u32x4 w; w.x = cvt_pk_bf16(v0[0], v0[1]); w.y = cvt_pk_bf16(v0[2], v0[3]); w.z = cvt_pk_bf16(v1[0], v1[1]); w.w = cvt_pk_bf16(v1[2], v1[3]);
                    *(pg8::u32x4*)(rowp + bj * 128) = w;
                    s += ((v0[0] * v0[0] + v0[1] * v0[1]) + (v0[2] * v0[2] + v0[3] * v0[3])) + ((v1[0] * v1[0] + v1[1] * v1[1]) + (v1[2] * v1[2] + v1[3] * v1[3]));
                }
                s += __shfl_xor(s, 16); s += __shfl_xor(s, 32);
                if (fq == 0) __hip_atomic_fetch_add(ss + row, ss_fix(s), __ATOMIC_RELAXED, __HIP_MEMORY_SCOPE_AGENT);
            }
    }
};

struct EpiGateUp {
    static constexpr bool PERM = true;
    bf16* H; const u64* ss; mutable int cpm; mutable float crs[2][4];
    __device__ __forceinline__ void operator()(const f32x4 (&acc)[2][2][4][2], const Unit& u, int wr, int wc, int fr, int fq) const {
        const int row0 = u.pm * 256 + wr * 64 + fr, col0 = u.pn * 128 + wc * 32 + 8 * fq;
        if (u.pm != cpm) {
            cpm = u.pm; u64 sq[2][4];
#pragma unroll
            for (int ai = 0; ai < 2; ++ai)
#pragma unroll
                for (int m = 0; m < 4; ++m) sq[ai][m] = ss[row0 + ai * 128 + m * 16];
#pragma unroll
            for (int ai = 0; ai < 2; ++ai)
#pragma unroll
                for (int m = 0; m < 4; ++m) crs[ai][m] = ss_rstd(sq[ai][m]);
        }
#pragma unroll
        for (int ai = 0; ai < 2; ++ai)
#pragma unroll
            for (int m = 0; m < 4; ++m) {
                const int row = row0 + ai * 128 + m * 16;
                const float rs = crs[ai][m], rs2 = rs * rs, rse = -1.4426950408889634f * rs;
                float h[8];
#pragma unroll
                for (int n = 0; n < 2; ++n)
#pragma unroll
                    for (int j = 0; j < 4; ++j) { const float ga = acc[ai][0][m][n][j], ua = acc[ai][1][m][n][j];
                        h[n * 4 + j] = (ga * ua) * __builtin_amdgcn_rcpf(1.f + __builtin_amdgcn_exp2f(rse * ga)) * rs2; }
                pg8::u32x4 w; w.x = cvt_pk_bf16(h[0], h[1]); w.y = cvt_pk_bf16(h[2], h[3]); w.z = cvt_pk_bf16(h[4], h[5]); w.w = cvt_pk_bf16(h[6], h[7]);
                *(pg8::u32x4*)(H + (size_t)row * DFF + col0) = w;
            }
    }
};

struct EpiSeqDft {
    static constexpr bool PERM = true;
    bf16* O; const float* avec; int tps;
    __device__ __forceinline__ void operator()(const f32x4 (&acc)[2][2][4][2], const Unit& u, int wr, int wc, int fr, int fq) const {
        const int row0 = u.pm * 256 + wr * 64 + fr, col0 = u.pn * 256 + wc * 32 + 8 * fq;
        const float* av = avec + (size_t)(u.pm / tps) * DM + col0;
        const float sg = (fr & 1) ? -1.f : 1.f;
        f32x4 a[2][2];
#pragma unroll
        for (int bj = 0; bj < 2; ++bj)
#pragma unroll
            for (int n = 0; n < 2; ++n) a[bj][n] = *(const f32x4*)(av + bj * 128 + 4 * n) * sg;
#pragma unroll
        for (int ai = 0; ai < 2; ++ai)
#pragma unroll
            for (int m = 0; m < 4; ++m) { bf16* rowp = O + (size_t)(row0 + ai * 128 + m * 16) * DM + col0;
#pragma unroll
                for (int bj = 0; bj < 2; ++bj) { const f32x4 v0 = acc[ai][bj][m][0] + a[bj][0], v1 = acc[ai][bj][m][1] + a[bj][1];
                    pg8::u32x4 w; w.x = cvt_pk_bf16(v0[0], v0[1]); w.y = cvt_pk_bf16(v0[2], v0[3]); w.z = cvt_pk_bf16(v1[0], v1[1]); w.w = cvt_pk_bf16(v1[2], v1[3]);
                    *(pg8::u32x4*)(rowp + bj * 128) = w; } }
    }
};

struct ProbSeqDftH {
    const bf16* Dm; const bf16* YT; int K, lda, ldb; int tps; int koff;
    __device__ __forceinline__ const char* a_ptr(const Unit& u) const { const int pmi = u.pm % tps; return (const char*)(Dm + (size_t)pmi * 256 * lda + koff); }
    __device__ __forceinline__ const char* b_ptr(const Unit& u) const { const int b = u.pm / tps; return (const char*)(YT + (size_t)b * DM * ldb + (size_t)u.pn * 256 * ldb + koff); }
};
struct EpiSeqE {
    static constexpr bool PERM = true;
    bf16* E; const float* avec; int tps;
    __device__ __forceinline__ void operator()(const f32x4 (&acc)[2][2][4][2], const Unit& u, int wr, int wc, int fr, int fq) const {
        const int row0 = u.pm * 256 + wr * 64 + fr, col0 = u.pn * 256 + wc * 32 + 8 * fq;
        const float* av = avec + (size_t)(u.pm / tps) * DM + col0;
        const float sg = (fr & 1) ? -1.f : 1.f;
        f32x4 a[2][2];
#pragma unroll
        for (int bj = 0; bj < 2; ++bj)
#pragma unroll
            for (int n = 0; n < 2; ++n) a[bj][n] = *(const f32x4*)(av + bj * 128 + 4 * n) * sg;
#pragma unroll
        for (int ai = 0; ai < 2; ++ai)
#pragma unroll
            for (int m = 0; m < 4; ++m) { bf16* rowp = E + (size_t)(row0 + ai * 128 + m * 16) * DM + col0;
#pragma unroll
                for (int bj = 0; bj < 2; ++bj) { const f32x4 v0 = acc[ai][bj][m][0] + a[bj][0], v1 = acc[ai][bj][m][1] + a[bj][1];
                    pg8::u32x4 w; w.x = cvt_pk_bf16(v0[0], v0[1]); w.y = cvt_pk_bf16(v0[2], v0[3]); w.z = cvt_pk_bf16(v1[0], v1[1]); w.w = cvt_pk_bf16(v1[2], v1[3]);
                    *(pg8::u32x4*)(rowp + bj * 128) = w; } }
    }
};
struct EpiSeqO {
    static constexpr bool PERM = true;
    const bf16* E; bf16* F; int tps; int S;
    __device__ __forceinline__ void operator()(const f32x4 (&acc)[2][2][4][2], const Unit& u, int wr, int wc, int fr, int fq) const {
        const int row0 = u.pm * 256 + wr * 64 + fr, col0 = u.pn * 256 + wc * 32 + 8 * fq;
        const int b = u.pm / tps, n0 = (u.pm % tps) * 256 + wr * 64 + fr;
#pragma unroll
        for (int ai = 0; ai < 2; ++ai) {
            pg8::u32x4 eq[4][2];
#pragma unroll
            for (int m = 0; m < 4; ++m) { const bf16* ep = E + (size_t)(row0 + ai * 128 + m * 16) * DM + col0;
#pragma unroll
                for (int bj = 0; bj < 2; ++bj) eq[m][bj] = *(const pg8::u32x4*)(ep + bj * 128); }
#pragma unroll
            for (int m = 0; m < 4; ++m) { const int n = n0 + ai * 128 + m * 16;
                bf16* rp = F + ((size_t)b * S + n) * DM + col0; bf16* rm = F + ((size_t)b * S + (S - n)) * DM + col0;
#pragma unroll
                for (int bj = 0; bj < 2; ++bj) { const pg8::u32x4 q = eq[m][bj];
                    const f32x4 e0 = {bf_lo(q.x), bf_hi(q.x), bf_lo(q.y), bf_hi(q.y)}, e1 = {bf_lo(q.z), bf_hi(q.z), bf_lo(q.w), bf_hi(q.w)};
                    const f32x4 p0 = e0 + acc[ai][bj][m][0], p1 = e1 + acc[ai][bj][m][1], q0 = e0 - acc[ai][bj][m][0], q1 = e1 - acc[ai][bj][m][1];
                    pg8::u32x4 w; w.x = cvt_pk_bf16(p0[0], p0[1]); w.y = cvt_pk_bf16(p0[2], p0[3]); w.z = cvt_pk_bf16(p1[0], p1[1]); w.w = cvt_pk_bf16(p1[2], p1[3]);
                    *(pg8::u32x4*)(rp + bj * 128) = w;
                    if (n > 0) { pg8::u32x4 x; x.x = cvt_pk_bf16(q0[0], q0[1]); x.y = cvt_pk_bf16(q0[2], q0[3]); x.z = cvt_pk_bf16(q1[0], q1[1]); x.w = cvt_pk_bf16(q1[2], q1[3]);
                        *(pg8::u32x4*)(rm + bj * 128) = x; } } }
        }
    }
};

struct EpiBf16Plain {
    static constexpr bool PERM = true;
    bf16* O; int ldc;
    __device__ __forceinline__ void operator()(const f32x4 (&acc)[2][2][4][2], const Unit& u, int wr, int wc, int fr, int fq) const {
        const int row0 = u.pm * 256 + wr * 64 + fr, col0 = u.pn * 256 + wc * 32 + 8 * fq;
#pragma unroll
        for (int ai = 0; ai < 2; ++ai)
#pragma unroll
            for (int m = 0; m < 4; ++m) { bf16* rowp = O + (size_t)(row0 + ai * 128 + m * 16) * ldc + col0;
#pragma unroll
                for (int bj = 0; bj < 2; ++bj) { const f32x4 v0 = acc[ai][bj][m][0], v1 = acc[ai][bj][m][1];
                    pg8::u32x4 w; w.x = cvt_pk_bf16(v0[0], v0[1]); w.y = cvt_pk_bf16(v0[2], v0[3]); w.z = cvt_pk_bf16(v1[0], v1[1]); w.w = cvt_pk_bf16(v1[2], v1[3]);
                    *(pg8::u32x4*)(rowp + bj * 128) = w; } }
    }
};

namespace attn {
constexpr int D = 128, NW = 8, QBLK = 32, KVBLK = 64;
constexpr float SCALE = 0.088388347648318440f;
constexpr float THR = 8.f;
using s16x4  = __attribute__((ext_vector_type(4))) short;
using f32x16 = __attribute__((ext_vector_type(16))) float;
#define KSWZ(row, colB) ((row) * 256 + ((colB) ^ (((row) & 7) << 4)))
#define SBAR() __builtin_amdgcn_sched_barrier(0)
__device__ __forceinline__ int crow(int r, int hi) { return (r & 3) + 8 * (r >> 2) + 4 * hi; }
__device__ __forceinline__ unsigned cvtpk(float lo, float hi) { unsigned r; asm volatile("v_cvt_pk_bf16_f32 %0, %1, %2" : "=v"(r) : "v"(lo), "v"(hi)); return r; }

__device__ __forceinline__ void partialSM(f32x16& p0, f32x16& p1, float& m_reg, float& mn, float& alpha) {
  constexpr float C = SCALE * 1.4426950408889634f;
  float pmax = p0[0]; for (int r = 1; r < 16; ++r) pmax = fmaxf(pmax, p0[r]); for (int r = 0; r < 16; ++r) pmax = fmaxf(pmax, p1[r]);
  { auto rr = __builtin_amdgcn_permlane32_swap(__float_as_uint(pmax), __float_as_uint(pmax), false, false);
    pmax = fmaxf(__uint_as_float(rr[0]), __uint_as_float(rr[1])); }
  if (__builtin_expect(__all(pmax - m_reg <= THR / SCALE), 1)) { mn = m_reg; alpha = 1.f; }
  else { mn = fmaxf(m_reg, pmax); alpha = __builtin_amdgcn_exp2f((m_reg - mn) * C); m_reg = mn; }
  float mnC = -mn * C;
  for (int r = 0; r < 16; ++r) p0[r] = fmaf(p0[r], C, mnC); for (int r = 0; r < 16; ++r) p1[r] = fmaf(p1[r], C, mnC);
  for (int r = 0; r < 16; ++r) p0[r] = __builtin_amdgcn_exp2f(p0[r]);
}
__device__ __forceinline__ void finishSM(f32x16& p0, f32x16& p1, float alpha, float& l_reg, bf16x8& pa0, bf16x8& pa1, bf16x8& pa2, bf16x8& pa3) {
  for (int r = 0; r < 16; ++r) p1[r] = __builtin_amdgcn_exp2f(p1[r]);
  float ps = 0; for (int r = 0; r < 16; ++r) ps += p0[r]; for (int r = 0; r < 16; ++r) ps += p1[r];
  { auto rr = __builtin_amdgcn_permlane32_swap(__float_as_uint(ps), __float_as_uint(ps), false, false);
    ps = __uint_as_float(rr[0]) + __uint_as_float(rr[1]); }
  l_reg = l_reg * alpha + ps;
#define PK4(P, BASE, OUT) do { unsigned a0 = cvtpk(P[BASE + 0], P[BASE + 1]), a1 = cvtpk(P[BASE + 2], P[BASE + 3]);   \
    unsigned b0 = cvtpk(P[BASE + 4], P[BASE + 5]), b1 = cvtpk(P[BASE + 6], P[BASE + 7]);                              \
    auto r0 = __builtin_amdgcn_permlane32_swap(a0, b0, false, false); auto r1 = __builtin_amdgcn_permlane32_swap(a1, b1, false, false); \
    v4u w = {r0[0], r1[0], r0[1], r1[1]}; OUT = *reinterpret_cast<bf16x8*>(&w); } while (0)
  PK4(p0, 0, pa0); PK4(p0, 8, pa1); PK4(p1, 0, pa2); PK4(p1, 8, pa3);
#undef PK4
}
__device__ __forceinline__ void qkt(f32x16& p0, f32x16& p1, const bf16* Ks, const bf16x8* qr, int r32, int hi) {
  p0 = f32x16{}; p1 = f32x16{};
  for (int d0 = 0; d0 < 8; ++d0) { int cb = (d0 * 16 + hi * 8) * 2;
    bf16x8 b0 = *reinterpret_cast<const bf16x8*>((const char*)Ks + KSWZ(r32, cb));
    bf16x8 b1 = *reinterpret_cast<const bf16x8*>((const char*)Ks + KSWZ(32 + r32, cb));
    p0 = __builtin_amdgcn_mfma_f32_32x32x16_bf16(b0, qr[d0], p0, 0, 0, 0);
    p1 = __builtin_amdgcn_mfma_f32_32x32x16_bf16(b1, qr[d0], p1, 0, 0, 0); }
}
__device__ __forceinline__ int v_st(int k, int c) { const int kk = (k & ~0xC) | ((k & 4) << 1) | ((k & 8) >> 1); return ((kk >> 3) * 4 + (c >> 5)) * 512 + ((kk & 7) * 32 + (c & 31)) * 2; }
__device__ __forceinline__ int v_rd_base(int lane) { return ((lane & 3) << 3) | (((lane >> 2) & 3) << 6) | (((lane >> 4) & 1) << 5) | (((lane >> 5) & 1) << 8); }
constexpr int v_rd_off(int d0, int ks, int half) { return d0 * 512 + ks * 4096 + half * 2048; }
template <int OFF> __device__ __forceinline__ s16x4 tr_read(int vb) {
  s16x4 r; asm volatile("ds_read_b64_tr_b16 %0, %1 offset:%2" : "=&v"(r) : "v"(vb), "i"(OFF) : "memory"); return r;
}
template <int D0> __device__ __forceinline__ void pv_one(f32x16& od, int vb, bf16x8 pa0, bf16x8 pa1, bf16x8 pa2, bf16x8 pa3) {
  const s16x4 l0 = tr_read<v_rd_off(D0, 0, 0)>(vb), h0 = tr_read<v_rd_off(D0, 0, 1)>(vb), l1 = tr_read<v_rd_off(D0, 1, 0)>(vb), h1 = tr_read<v_rd_off(D0, 1, 1)>(vb);
  const s16x4 l2 = tr_read<v_rd_off(D0, 2, 0)>(vb), h2 = tr_read<v_rd_off(D0, 2, 1)>(vb), l3 = tr_read<v_rd_off(D0, 3, 0)>(vb), h3 = tr_read<v_rd_off(D0, 3, 1)>(vb);
  asm volatile("s_waitcnt lgkmcnt(0)" ::: "memory"); SBAR();
#define PK(L, H) (bf16x8){L[0], L[1], L[2], L[3], H[0], H[1], H[2], H[3]}
  od = __builtin_amdgcn_mfma_f32_32x32x16_bf16(pa0, PK(l0, h0), od, 0, 0, 0);
  od = __builtin_amdgcn_mfma_f32_32x32x16_bf16(pa1, PK(l1, h1), od, 0, 0, 0);
  od = __builtin_amdgcn_mfma_f32_32x32x16_bf16(pa2, PK(l2, h2), od, 0, 0, 0);
  od = __builtin_amdgcn_mfma_f32_32x32x16_bf16(pa3, PK(l3, h3), od, 0, 0, 0);
#undef PK
}
__device__ __forceinline__ void pv_d0(f32x16* o, int vb, bf16x8 pa0, bf16x8 pa1, bf16x8 pa2, bf16x8 pa3) {
  pv_one<0>(o[0], vb, pa0, pa1, pa2, pa3); pv_one<1>(o[1], vb, pa0, pa1, pa2, pa3); pv_one<2>(o[2], vb, pa0, pa1, pa2, pa3); pv_one<3>(o[3], vb, pa0, pa1, pa2, pa3);
}

}

namespace attn2 {
using namespace attn;
constexpr int K_OFF = 0, V_OFF = 32768, P_OFF = 98304, X_OFF = 131072, LDS_ATTN2 = X_OFF + 4096;
__device__ __forceinline__ int opaque0() { int z = 0; asm volatile("" : "+v"(z)); return z; }
#define A2_BAR() do { asm volatile("s_waitcnt lgkmcnt(0)" ::: "memory"); __builtin_amdgcn_s_barrier(); asm volatile("" ::: "memory"); } while (0)

__device__ __forceinline__ void unit(const bf16* __restrict__ kvb, int q0, int seq, bf16* __restrict__ Oc, float lam, unsigned* __restrict__ stash, char* lds) {
  const int tid = threadIdx.x, wid = __builtin_amdgcn_readfirstlane(tid >> 6), lane = tid & 63, hi = lane >> 5;
  const int p = wid & 3, NT = seq / KVBLK;
  char* Kl = lds + K_OFF; char* Vl = lds + V_OFF; char* Pl = lds + P_OFF + p * 8192;
  float* X = (float*)(lds + X_OFF + p * 1024);
  for (int pass = 0; pass < 2; ++pass) {
    const int c = 1 - pass;
    const bf16* Kg = kvb + DM + c * 128; const bf16* Vg = kvb + 2 * DM;
    if (wid < 4) {
      const int zA = opaque0(); const int r32 = (lane & 31) + zA, lanea = lane + zA;
      bf16x8 qr[8];
      const bf16* Qw = kvb + (long)(q0 + p * 32 + r32) * NQKV + c * 128 + hi * 8;
#pragma unroll
      for (int d0 = 0; d0 < 8; ++d0) qr[d0] = *reinterpret_cast<const bf16x8*>(Qw + d0 * 16);
      float l_reg = 0.f;
      f32x16 cinit;
#pragma unroll
      for (int r = 0; r < 16; ++r) cinit[r] = 0.f;
      A2_BAR();
      for (int s = 0; s < NT; ++s) {
        f32x16 p0, p1;
        { const char* Ks = Kl + (s & 1) * 16384;
#pragma unroll
          for (int d0 = 0; d0 < 8; ++d0) { const int cb = (d0 * 16 + hi * 8) * 2;
            const bf16x8 b0 = *reinterpret_cast<const bf16x8*>(Ks + KSWZ(r32, cb)), b1 = *reinterpret_cast<const bf16x8*>(Ks + KSWZ(32 + r32, cb));
            p0 = __builtin_amdgcn_mfma_f32_32x32x16_bf16(b0, qr[d0], d0 == 0 ? cinit : p0, 0, 0, 0);
            p1 = __builtin_amdgcn_mfma_f32_32x32x16_bf16(b1, qr[d0], d0 == 0 ? cinit : p1, 0, 0, 0); } }
        float pmax = fmaxf(p0[0], p1[0]);
#pragma unroll
        for (int r = 1; r < 16; ++r) pmax = fmaxf(fmaxf(pmax, p0[r]), p1[r]);
        { auto rr = __builtin_amdgcn_permlane32_swap(__float_as_uint(pmax), __float_as_uint(pmax), false, false);
          pmax = fmaxf(__uint_as_float(rr[0]), __uint_as_float(rr[1])); }
        float alpha = 1.f;
        if (__builtin_expect(s == 0 || !__all(pmax <= THR * 1.4426950408889634f), 0)) {
          const float d = s == 0 ? pmax : fmaxf(pmax, 0.f);
          alpha = s == 0 ? 1.f : __builtin_amdgcn_exp2f(-d);
#pragma unroll
          for (int r = 0; r < 16; ++r) { p0[r] -= d; p1[r] -= d; cinit[r] -= d; }
        }
#pragma unroll
        for (int r = 0; r < 16; ++r) { p0[r] = __builtin_amdgcn_exp2f(p0[r]); p1[r] = __builtin_amdgcn_exp2f(p1[r]); }
        unsigned u0[8], u1[8];
#pragma unroll
        for (int r = 0; r < 8; ++r) { u0[r] = cvtpk(p0[2 * r], p0[2 * r + 1]); u1[r] = cvtpk(p1[2 * r], p1[2 * r + 1]); }
        float ps = p0[0] + p1[0];
#pragma unroll
        for (int r = 1; r < 16; ++r) ps += p0[r] + p1[r];
        { auto rr = __builtin_amdgcn_permlane32_swap(__float_as_uint(ps), __float_as_uint(ps), false, false);
          ps = __uint_as_float(rr[0]) + __uint_as_float(rr[1]); }
        l_reg = l_reg * alpha + ps;
        { char* Ps = Pl + (s & 1) * 4096 + (lanea & 31) * 16 + (lanea >> 5) * 8;
          *(v2u*)(Ps)        = (v2u){u0[0], u0[1]}; *(v2u*)(Ps + 512)        = (v2u){u0[2], u0[3]};
          *(v2u*)(Ps + 1024) = (v2u){u0[4], u0[5]}; *(v2u*)(Ps + 1024 + 512) = (v2u){u0[6], u0[7]};
          *(v2u*)(Ps + 2048) = (v2u){u1[0], u1[1]}; *(v2u*)(Ps + 2048 + 512) = (v2u){u1[2], u1[3]};
          *(v2u*)(Ps + 3072) = (v2u){u1[4], u1[5]}; *(v2u*)(Ps + 3072 + 512) = (v2u){u1[6], u1[7]}; }
        const bool resc = __any(alpha < 1.f);
        if (resc && hi == 0) X[(s & 1) * 32 + r32] = alpha;
        if (lane == 0) ((unsigned*)X)[64 + (s & 1)] = resc ? 1u : 0u;
        A2_BAR();
      }
      if (hi == 0) X[128 + r32] = l_reg;
      A2_BAR();
      if (pass == 1) A2_BAR();
    } else {
      const int zB = opaque0(); const int laneb = lane + zB;
      const int bw = wid - 4, g = laneb >> 4, q16 = laneb & 15, pq = (laneb & 15) >> 2, pp = laneb & 3;
      unsigned voffK[4], voffV[4];
#pragma unroll
      for (int i = 0; i < 4; ++i) {
        const int key = 16 * bw + 4 * i + (laneb >> 4), cch = (laneb & 15) ^ ((4 * i + (laneb >> 4)) & 7);
        voffK[i] = (unsigned)(key * NQKV + cch * 8) * 2u;
        const int g8 = 2 * bw + (i >> 1), chq = ((i & 1) << 1) + (laneb >> 5), r7 = (laneb >> 2) & 7, cx = laneb & 3;
        const int vkey = 8 * g8 + r7, vch = 4 * chq + (cx ^ (2 * (g8 & 1) + (r7 >> 2)));
        voffV[i] = (unsigned)(vkey * NQKV + vch * 8) * 2u;
      }
      const char* Kgb = (const char*)Kg; const char* Vgb = (const char*)Vg;
      LAS unsigned char* Kd = (LAS unsigned char*)(Kl) + bw * 4096; LAS unsigned char* Vd = (LAS unsigned char*)(Vl) + bw * 4096;
#define A2_DMAK(tile, slot) do { _Pragma("unroll") for (int i = 0; i < 4; ++i) \
        __builtin_amdgcn_global_load_lds((const unsigned*)(Kgb + (size_t)(tile) * (KVBLK * NQKV * 2) + voffK[i]), (LAS unsigned*)(Kd + (slot) * 16384 + i * 1024), 16, 0, 0); } while (0)
#define A2_DMAV(tile, slot) do { _Pragma("unroll") for (int e = 0; e < 2; ++e) _Pragma("unroll") for (int i = 0; i < 4; ++i) \
        __builtin_amdgcn_global_load_lds((const unsigned*)(Vgb + (size_t)(tile) * (KVBLK * NQKV * 2) + e * 256 + voffV[i]), (LAS unsigned*)(Vd + (slot) * 32768 + e * 16384 + i * 1024), 16, 0, 0); } while (0)
#define A2_BARV() do { asm volatile("s_waitcnt vmcnt(0) lgkmcnt(0)" ::: "memory"); __builtin_amdgcn_s_barrier(); asm volatile("" ::: "memory"); } while (0)
#define A2_DMA1(vo, sbase, ldsaddr) asm volatile("s_mov_b32 m0, %2\n\ts_nop 0\n\tglobal_load_lds_dwordx4 %0, %1" :: "v"(vo), "s"(sbase), "s"(ldsaddr) : "memory", "m0")
#define A2_K1(i, tile, slot) A2_DMA1(voffK[i], Kgb + (size_t)(tile) * (KVBLK * NQKV * 2), (unsigned)(uintptr_t)(Kd + (slot) * 16384 + (i) * 1024))
#define A2_V1(e, i, tile, slot) A2_DMA1(voffV[i], Vgb + (size_t)(tile) * (KVBLK * NQKV * 2) + (e) * 256, (unsigned)(uintptr_t)(Vd + (slot) * 32768 + (e) * 16384 + (i) * 1024))
#define A2_RD16(F, B0, B1, IMM) do { F[0] = tr_read<(IMM)>(B0); F[1] = tr_read<(IMM) + 256>(B1); } while (0)
#define A2_WL(n) do { asm volatile("s_waitcnt lgkmcnt(" #n ")" ::: "memory"); SBAR(); } while (0)
#define A2_MM16(OA, OB, F, PA, PB) do { const bf16x8 _v = (bf16x8){F[0][0], F[0][1], F[0][2], F[0][3], F[1][0], F[1][1], F[1][2], F[1][3]}; \
        OA = __builtin_amdgcn_mfma_f32_16x16x32_bf16(_v, PA, OA, 0, 0, 0); OB = __builtin_amdgcn_mfma_f32_16x16x32_bf16(_v, PB, OB, 0, 0, 0); SBAR(); } while (0)
      const int rh = bw >> 1, ch = bw & 1;
      char* PlA0 = lds + P_OFF + (2 * rh) * 8192; char* PlA1 = PlA0 + 8192;
      float* XA0 = (float*)(lds + X_OFF + (2 * rh) * 1024); float* XA1 = XA0 + 256;
      f32x4 oacc[8][4];
#pragma unroll
      for (int cc = 0; cc < 8; ++cc)
#pragma unroll
        for (int qb = 0; qb < 4; ++qb) oacc[cc][qb] = (f32x4){0.f, 0.f, 0.f, 0.f};
      const int vrel = 2048 * g + 64 * pq + 8 * (pp & 1) + ch * 16384;
      const int vr00 = vrel + 32 * (0 ^ (g & 1)) + 16 * ((pp >> 1) ^ 0), vr01 = vrel + 32 * (0 ^ (g & 1)) + 16 * ((pp >> 1) ^ 1);
      const int vr10 = vrel + 32 * (1 ^ (g & 1)) + 16 * ((pp >> 1) ^ 0), vr11 = vrel + 32 * (1 ^ (g & 1)) + 16 * ((pp >> 1) ^ 1);
      const int prel0 = (g >> 1) * 1024 + (q16 + 32 * (g & 1)) * 16;
      A2_DMAK(0, 0);
      A2_BARV();
      { const int kt = 1 < NT ? 1 : 0; A2_DMAK(kt, 1); A2_DMAV(0, 0); }
      A2_BARV();
      for (int s = 1; s <= NT; ++s) {
        const int kt = (s + 1 < NT) ? s + 1 : NT - 1, ks = (s + 1) & 1;
        const int vt = (s < NT) ? s : NT - 1, vs = s & 1;
        const bool kdo = s + 1 < NT, vdo = s < NT;
        const int t = (s - 1) & 1;
        bf16x8 pf[4][2];
        { const char* P0 = PlA0 + t * 4096 + prel0; const char* P1 = PlA1 + t * 4096 + prel0;
          pf[0][0] = *(const bf16x8*)(P0); pf[0][1] = *(const bf16x8*)(P0 + 2048); pf[1][0] = *(const bf16x8*)(P0 + 256); pf[1][1] = *(const bf16x8*)(P0 + 2048 + 256);
          pf[2][0] = *(const bf16x8*)(P1); pf[2][1] = *(const bf16x8*)(P1 + 2048); pf[3][0] = *(const bf16x8*)(P1 + 256); pf[3][1] = *(const bf16x8*)(P1 + 2048 + 256); }
        const unsigned fl0 = *((volatile LAS unsigned*)XA0 + 64 + t), fl1 = *((volatile LAS unsigned*)XA1 + 64 + t);
        if (fl0 | fl1) {
          const float a0 = fl0 ? XA0[t * 32 + q16] : 1.f, a1 = fl0 ? XA0[t * 32 + 16 + q16] : 1.f, a2 = fl1 ? XA1[t * 32 + q16] : 1.f, a3 = fl1 ? XA1[t * 32 + 16 + q16] : 1.f;
#pragma unroll
          for (int cc = 0; cc < 8; ++cc) { oacc[cc][0] *= a0; oacc[cc][1] *= a1; oacc[cc][2] *= a2; oacc[cc][3] *= a3; }
        }
        const int vsl = (int)(uintptr_t)(Vl + t * 32768);
        const int vb00 = vsl + vr00, vb01 = vsl + vr01, vb10 = vsl + vr10, vb11 = vsl + vr11;
        s16x4 F0[2], F1[2], F2[2], F3[2];
#define A2_MM4(CC, F, KB) do { const bf16x8 _v = (bf16x8){F[0][0], F[0][1], F[0][2], F[0][3], F[1][0], F[1][1], F[1][2], F[1][3]}; \
        oacc[CC][0] = __builtin_amdgcn_mfma_f32_16x16x32_bf16(_v, pf[0][KB], oacc[CC][0], 0, 0, 0); oacc[CC][1] = __builtin_amdgcn_mfma_f32_16x16x32_bf16(_v, pf[1][KB], oacc[CC][1], 0, 0, 0); \
        oacc[CC][2] = __builtin_amdgcn_mfma_f32_16x16x32_bf16(_v, pf[2][KB], oacc[CC][2], 0, 0, 0); oacc[CC][3] = __builtin_amdgcn_mfma_f32_16x16x32_bf16(_v, pf[3][KB], oacc[CC][3], 0, 0, 0); SBAR(); } while (0)
        A2_RD16(F0, vb00, vb01, 0); A2_RD16(F1, vb00, vb01, 8192); A2_RD16(F2, vb10, vb11, 0);
        A2_WL(4); A2_RD16(F3, vb10, vb11, 8192); if (kdo) { A2_K1(0, kt, ks); A2_K1(1, kt, ks); } A2_MM4(0, F0, 0);
        A2_WL(4); A2_RD16(F0, vb00, vb01, 512); if (kdo) { A2_K1(2, kt, ks); A2_K1(3, kt, ks); } A2_MM4(0, F1, 1);
        A2_WL(4); A2_RD16(F1, vb00, vb01, 8704); if (vdo) { A2_V1(0, 0, vt, vs); A2_V1(0, 1, vt, vs); } A2_MM4(1, F2, 0);
        A2_WL(4); A2_RD16(F2, vb10, vb11, 512); if (vdo) { A2_V1(0, 2, vt, vs); A2_V1(0, 3, vt, vs); } A2_MM4(1, F3, 1);
        A2_WL(4); A2_RD16(F3, vb10, vb11, 8704); if (vdo) { A2_V1(1, 0, vt, vs); A2_V1(1, 1, vt, vs); } A2_MM4(2, F0, 0);
        A2_WL(4); A2_RD16(F0, vb00, vb01, 1024); if (vdo) { A2_V1(1, 2, vt, vs); A2_V1(1, 3, vt, vs); } A2_MM4(2, F1, 1);
        A2_WL(4); A2_RD16(F1, vb00, vb01, 9216); A2_MM4(3, F2, 0);
        A2_WL(4); A2_RD16(F2, vb10, vb11, 1024); A2_MM4(3, F3, 1);
        A2_WL(4); A2_RD16(F3, vb10, vb11, 9216); A2_MM4(4, F0, 0);
        A2_WL(4); A2_RD16(F0, vb00, vb01, 1536); A2_MM4(4, F1, 1);
        A2_WL(4); A2_RD16(F1, vb00, vb01, 9728); A2_MM4(5, F2, 0);
        A2_WL(4); A2_RD16(F2, vb10, vb11, 1536); A2_MM4(5, F3, 1);
        A2_WL(4); A2_RD16(F3, vb10, vb11, 9728); A2_MM4(6, F0, 0);
        A2_WL(4); A2_MM4(6, F1, 1);
        A2_WL(2); A2_MM4(7, F2, 0);
        A2_WL(0); A2_MM4(7, F3, 1);
#undef A2_MM4
        A2_BARV();
      }
      const int zE = opaque0(); const int lanee = lane + zE, qe = (lane & 15) + zE, ge = (lane >> 4) + zE;
      float rl[4];
      rl[0] = __builtin_amdgcn_rcpf(XA0[128 + qe]); rl[1] = __builtin_amdgcn_rcpf(XA0[128 + 16 + qe]); rl[2] = __builtin_amdgcn_rcpf(XA1[128 + qe]); rl[3] = __builtin_amdgcn_rcpf(XA1[128 + 16 + qe]);
      if (pass == 0) {
        GAS v4u* sp = (GAS v4u*)stash + lanee;
#pragma unroll
        for (int cc = 0; cc < 8; ++cc)
#pragma unroll
          for (int jp = 0; jp < 2; ++jp) { const float c0 = -lam * rl[2 * jp], c1 = -lam * rl[2 * jp + 1];
            v4u tt; tt.x = cvtpk(oacc[cc][2 * jp][0] * c0, oacc[cc][2 * jp][1] * c0); tt.y = cvtpk(oacc[cc][2 * jp][2] * c0, oacc[cc][2 * jp][3] * c0);
            tt.z = cvtpk(oacc[cc][2 * jp + 1][0] * c1, oacc[cc][2 * jp + 1][1] * c1); tt.w = cvtpk(oacc[cc][2 * jp + 1][2] * c1, oacc[cc][2 * jp + 1][3] * c1);
            *sp = tt; sp += 64; asm volatile("" : "+v"(sp) :: "memory"); }
      } else {
        float sq[4] = {0.f, 0.f, 0.f, 0.f};
        v4u ro[4][4];
        const GAS v4u* sp = (const GAS v4u*)stash + lanee;
#pragma unroll
        for (int h = 0; h < 2; ++h) {
          v4u w[8];
#pragma unroll
          for (int i = 0; i < 8; ++i) { w[i] = *sp; sp += 64; asm volatile("" : "+v"(sp)); }
          asm volatile("" ::: "memory");
#pragma unroll
          for (int pr = 0; pr < 2; ++pr) {
            v2u wd[2][4];
#pragma unroll
            for (int e = 0; e < 2; ++e) { const int lc = 2 * pr + e, cc = 4 * h + lc;
#pragma unroll
              for (int jp = 0; jp < 2; ++jp) { const v4u q = w[2 * lc + jp]; const int qa = 2 * jp, qb2 = 2 * jp + 1;
                const float a0 = fmaf(oacc[cc][qa][0], rl[qa], bf_lo(q.x)), a1 = fmaf(oacc[cc][qa][1], rl[qa], bf_hi(q.x)), a2 = fmaf(oacc[cc][qa][2], rl[qa], bf_lo(q.y)), a3 = fmaf(oacc[cc][qa][3], rl[qa], bf_hi(q.y));
                const float b0 = fmaf(oacc[cc][qb2][0], rl[qb2], bf_lo(q.z)), b1 = fmaf(oacc[cc][qb2][1], rl[qb2], bf_hi(q.z)), b2 = fmaf(oacc[cc][qb2][2], rl[qb2], bf_lo(q.w)), b3 = fmaf(oacc[cc][qb2][3], rl[qb2], bf_hi(q.w));
                sq[qa] = fmaf(a0, a0, sq[qa]); sq[qa] = fmaf(a1, a1, sq[qa]); sq[qa] = fmaf(a2, a2, sq[qa]); sq[qa] = fmaf(a3, a3, sq[qa]);
                sq[qb2] = fmaf(b0, b0, sq[qb2]); sq[qb2] = fmaf(b1, b1, sq[qb2]); sq[qb2] = fmaf(b2, b2, sq[qb2]); sq[qb2] = fmaf(b3, b3, sq[qb2]);
                wd[e][qa].x = cvtpk(a0, a1); wd[e][qa].y = cvtpk(a2, a3); wd[e][qb2].x = cvtpk(b0, b1); wd[e][qb2].y = cvtpk(b2, b3); } }
#pragma unroll
            for (int qb = 0; qb < 4; ++qb) {
              const auto ax = __builtin_amdgcn_permlane16_swap(wd[0][qb].x, wd[1][qb].x, false, false), ay = __builtin_amdgcn_permlane16_swap(wd[0][qb].y, wd[1][qb].y, false, false);
              ro[2 * h + pr][qb] = (v4u){ax[0], ay[0], ax[1], ay[1]}; }
          }
          asm volatile("" ::: "memory");
        }
#pragma unroll
        for (int qb = 0; qb < 4; ++qb) { sq[qb] += __shfl_xor(sq[qb], 16); sq[qb] += __shfl_xor(sq[qb], 32); }
        { float* XS = (float*)(lds + X_OFF + bw * 1024) + 192;
          if (ge == 0) { XS[qe] = sq[0]; XS[16 + qe] = sq[1]; XS[32 + qe] = sq[2]; XS[48 + qe] = sq[3]; } }
        A2_BAR();
        float rs[4];
        { const float* XP = (const float*)(lds + X_OFF + (bw ^ 1) * 1024) + 192;
#pragma unroll
          for (int qb = 0; qb < 4; ++qb) rs[qb] = rsqrtf((sq[qb] + XP[16 * qb + qe]) * (1.f / VD) + SUBLN_EPS); }
        GAS bf16* rp = (GAS bf16*)Oc + (long)(64 * rh + qe) * DM + 128 * ch + 16 * (ge & 1) + 8 * (ge >> 1); asm volatile("" : "+v"(rp) :: "memory");
#define A2_RS(q, r) cvtpk(bf_lo(q) * (r), bf_hi(q) * (r))
#pragma unroll
        for (int P = 0; P < 4; ++P)
#pragma unroll
          for (int qb = 0; qb < 4; ++qb) { const v4u q = ro[P][qb]; v4u o; o.x = A2_RS(q.x, rs[qb]); o.y = A2_RS(q.y, rs[qb]); o.z = A2_RS(q.z, rs[qb]); o.w = A2_RS(q.w, rs[qb]);
            *(GAS v4u*)(rp + (long)(16 * qb) * DM + 32 * P) = o; }
#undef A2_RS
      }
#undef A2_DMAK
#undef A2_DMAV
#undef A2_BARV
#undef A2_K1
#undef A2_V1
#undef A2_RD16
#undef A2_WL
#undef A2_MM16
    }
  }
}
}

#define XB_TMO      128
#define XB_XCNT(j)  (256  + 64 * (j))
#define XB_XSUB(j)  (1280 + 64 * (j))
#define XB_XGEN(j)  (2304 + 64 * (j))
#define XB_TOP      3328
#define XB_TOPGEN   3392
#define XCD_BAR_WORDS 3456
#define XB_SPIN_CAP (1u << 20)

__device__ __forceinline__ unsigned xb_ld(unsigned* p)              { return __hip_atomic_load(p, __ATOMIC_RELAXED, __HIP_MEMORY_SCOPE_AGENT); }
__device__ __forceinline__ unsigned xb_add(unsigned* p, unsigned v) { return __hip_atomic_fetch_add(p, v, __ATOMIC_RELAXED, __HIP_MEMORY_SCOPE_AGENT); }
__device__ __forceinline__ unsigned xb_xcc_id() { return (unsigned)__builtin_amdgcn_s_getreg((3 << 11) | 20) & 0xFu; }
#define XB_SPIN(cond, bar) do { unsigned _sp = 0; while (cond) { __builtin_amdgcn_s_sleep(1); \
    if ((++_sp & 255u) == 0u) { if (xb_ld(&(bar)[XB_TMO])) break; if (_sp > XB_SPIN_CAP) { atomicAdd(&(bar)[XB_TMO], 1u); break; } } } } while (0)

struct XcdBarrier { unsigned* bar; unsigned x; volatile LAS unsigned* st; };

__device__ __forceinline__ XcdBarrier xcd_barrier_post(unsigned* bar, volatile LAS unsigned* st) {
    XcdBarrier b; b.bar = bar; b.x = xb_xcc_id(); b.st = st;
    if (threadIdx.x == 0) (void)xb_add(&bar[XB_XCNT(b.x)], 1u);
    return b;
}
__device__ __forceinline__ void xcd_barrier_complete(unsigned* bar, unsigned x, unsigned& nloc, unsigned& nx) {
    const unsigned G = gridDim.x * gridDim.y * gridDim.z;
    unsigned sum, cnt, mine, sp = 0u;
    for (;;) {
        sum = 0u; cnt = 0u; mine = 0u;
#pragma unroll
        for (unsigned j = 0; j < 16; ++j) { const unsigned c = xb_ld(&bar[XB_XCNT(j)]); sum += c; cnt += (c > 0u) ? 1u : 0u; mine = (j == x) ? c : mine; }
        if (sum == G) break;
        __builtin_amdgcn_s_sleep(1);
        if ((++sp & 255u) == 0u) { if (xb_ld(&bar[XB_TMO])) break; if (sp > XB_SPIN_CAP) { atomicAdd(&bar[XB_TMO], 1u); break; } }
    }
    nloc = mine > 0u ? mine : 1u; nx = cnt > 0u ? cnt : 1u;
}
__device__ __forceinline__ void xcd_barrier(const XcdBarrier& b) {
    asm volatile("s_waitcnt vmcnt(0)" ::: "memory");
    __syncthreads();
    if (threadIdx.x == 0) {
        unsigned* bar = b.bar;
        __builtin_amdgcn_s_waitcnt(0);
        unsigned nloc = b.st[0], nx = b.st[1];
        if (nloc == 0u) { xcd_barrier_complete(bar, b.x, nloc, nx); b.st[0] = nloc; b.st[1] = nx; }
        const unsigned old = xb_add(&bar[XB_XSUB(b.x)], 1u);
        const unsigned gen = old / nloc;
        if (old + 1u == (gen + 1u) * nloc) {
            __builtin_amdgcn_fence(__ATOMIC_RELEASE, "agent");
            asm volatile("s_waitcnt vmcnt(0)" ::: "memory");
            const unsigned og = xb_add(&bar[XB_TOP], 1u);
            const unsigned tg = og / nx;
            if (og + 1u == (tg + 1u) * nx) xb_add(&bar[XB_TOPGEN], 1u);
            else XB_SPIN(xb_ld(&bar[XB_TOPGEN]) == tg, bar);
            __builtin_amdgcn_fence(__ATOMIC_ACQUIRE, "agent");
            xb_add(&bar[XB_XGEN(b.x)], 1u);
            asm volatile("s_waitcnt vmcnt(0)" ::: "memory");
        } else {
            XB_SPIN(xb_ld(&bar[XB_XGEN(b.x)]) == gen, bar);
            __builtin_amdgcn_fence(__ATOMIC_ACQUIRE, "agent");
            asm volatile("s_waitcnt vmcnt(0)" ::: "memory");
        }
    }
    __syncthreads();
}

constexpr int NWAVES = 8;
constexpr int RING_OFF = 0, RING_BYTES = 131072;
constexpr int LDSCTL_OFF = 143360, MISC_OFF = LDSCTL_OFF + 320;
constexpr int ROPE_LDS_OFF = 147456;
constexpr int LDS_BYTES = 163840;

struct Args { const float* in[15]; float* out; unsigned char* ws; int ph_lo, ph_hi; };
static_assert(sizeof(Args) == 15 * 8 + 8 + 8 + 8, "Args has no padding");

template <int MODE>
__device__ __forceinline__ void p0_transpose_item(const float* __restrict__ W, int K, int N, bf16* __restrict__ WT, const float* __restrict__ gain, int gmask, float gscale, LAS float* scr, int item, int lane) {
    const int nblk = N / 32, kb = item / nblk, nb = item % nblk, k0 = 64 * kb, n0 = 32 * nb;
    const float* src = W + (size_t)(k0 + (lane >> 5)) * N + n0 + (lane & 31);
    float v[32];
#pragma unroll
    for (int i = 0; i < 32; ++i) v[i] = src[(size_t)(2 * i) * N];
    const int c = lane & 7;
    f32x4 g0 = {gscale, gscale, gscale, gscale}, g1 = g0;
    if (gain) { const int kg = (k0 + 8 * c) & gmask; g0 = *(const f32x4*)(gain + kg) * gscale; g1 = *(const f32x4*)(gain + kg + 4) * gscale; }
#pragma unroll
    for (int i = 0; i < 32; ++i) scr[(2 * i + (lane >> 5)) * 33 + (lane & 31)] = v[i];
    LDS_WAIT(); asm volatile("" ::: "memory");
    int d0 = n0;
    if (MODE == 1) { const int cc = n0 < DFF ? n0 : n0 - DFF; d0 = (cc >> 7) * 256 + (cc & 127) + (n0 < DFF ? 0 : 128); }
#pragma unroll
    for (int j = 0; j < 4; ++j) { const int n = (lane >> 3) + 8 * j; const LAS float* s = scr + (8 * c) * 33 + n;
        v4u o; o.x = cvt_pk_bf16(s[0 * 33] * g0[0], s[1 * 33] * g0[1]); o.y = cvt_pk_bf16(s[2 * 33] * g0[2], s[3 * 33] * g0[3]);
        o.z = cvt_pk_bf16(s[4 * 33] * g1[0], s[5 * 33] * g1[1]); o.w = cvt_pk_bf16(s[6 * 33] * g1[2], s[7 * 33] * g1[3]);
        *(v4u*)(WT + (size_t)(d0 + n) * K + k0 + 8 * c) = o; }
    LDS_WAIT(); asm volatile("" ::: "memory");
}

__global__ void __launch_bounds__(NWAVES * 64, 2) fwd_kernel(Args args) {
    extern __shared__ __attribute__((aligned(16))) unsigned char lds[];
    LAS unsigned char* ldsl = (LAS unsigned char*)lds;
    volatile LAS unsigned* MISC = (volatile LAS unsigned*)(ldsl + MISC_OFF);
    const int tid = threadIdx.x, lane = tid & 63, wave = __builtin_amdgcn_readfirstlane(tid >> 6);
    const int G = gridDim.x, bx = blockIdx.x;
    const int vcu = (G % 8 == 0) ? (bx % 8) * (G / 8) + bx / 8 : bx;
    const int gw = vcu * NWAVES + wave, NGW = G * NWAVES;
    unsigned char* ws = args.ws;
    gu32* ctl = (gu32*)(ws + WS_CTL);

    const float* x_p = args.in[0]; const float* x_s = args.in[1];
    const float* norm_mix = args.in[2]; const float* norm_ffn = args.in[3]; const float* norm_final = args.in[4];
    const float* w_qkv = args.in[5]; const float* w_o = args.in[6];
    const float* lq1 = args.in[7]; const float* lk1 = args.in[8]; const float* lq2 = args.in[9]; const float* lk2 = args.in[10];
    const float* subln = args.in[11]; const float* w_f = args.in[12]; const float* w_gu = args.in[13]; const float* w_dn = args.in[14];
    float* out = args.out;

    u64* ss0 = (u64*)(ws + WS_SS); u64* ss1 = ss0 + NTOK; u64* ss2 = ss1 + NTOK; u64* ss3 = ss2 + NTOK; u64* ss4 = ss3 + NTOK;
    float* rcos = (float*)(ws + WS_ROPE); float* rsin = rcos + SEQ_P * 16;
    bf16* Wc = (bf16*)(ws + WS_WC); bf16* D4096 = (bf16*)(ws + WS_D4096); bf16* D2048 = (bf16*)(ws + WS_D2048);
    bf16* Wqkv_t = (bf16*)(ws + WS_WQKV); bf16* Wo_t = (bf16*)(ws + WS_WO); bf16* Wf_t = (bf16*)(ws + WS_WF);
    bf16* Wgu_t0 = (bf16*)(ws + WS_WGU0); bf16* Wgu_t1 = (bf16*)(ws + WS_WGU1); bf16* Wd_t0 = (bf16*)(ws + WS_WD0); bf16* Wd_t1 = (bf16*)(ws + WS_WD1);
    bf16* XB = (bf16*)(ws + WS_XB); bf16* QKV = (bf16*)(ws + WS_QKV); bf16* HB = (bf16*)(ws + WS_HB);
    bf16* OB = (bf16*)(ws + WS_OB); bf16* YT = (bf16*)(ws + WS_YT); bf16* OC = (bf16*)(ws + WS_OC); bf16* FB = (bf16*)(ws + WS_F); bf16* XF = (bf16*)(ws + WS_XF); float* avec = (float*)(ws + WS_AVEC);

    for (int u = tid; u < (LDS_BYTES - LDSCTL_OFF) / 4; u += NWAVES * 64) ((LAS unsigned*)(ldsl + LDSCTL_OFF))[u] = 0u;
    __syncthreads();
#if MK_PER_PHASE
    XcdBarrier bar; bar.bar = (unsigned*)(ctl + CW_BAR); bar.x = 0; bar.st = nullptr;
#define GRID_BAR() do { } while (0)
#else
    XcdBarrier bar = xcd_barrier_post((unsigned*)(ctl + CW_BAR), MISC + 8);
#define GRID_BAR() xcd_barrier(bar)
#endif
    const int lo = args.ph_lo, hi = args.ph_hi;
#define IN(k) (lo <= (k) && (k) < hi)
#define BOTH(k) (IN(k) && IN((k) + 1))

    if (IN(0)) {
      {
        LAS float* scr = (LAS float*)(ldsl + RING_OFF + wave * 16384);
        constexpr int I_QKV = (DM / 64) * (NQKV / 32), I_O = (DM / 64) * (DM / 32), I_GU = (DM / 64) * (NGU / 32), I_D = (DFF / 64) * (DM / 32);
        constexpr int NITEMS = I_QKV + 2 * I_O + 2 * I_GU + 2 * I_D;
        for (int it = gw; it < NITEMS; it += NGW) {
            int r = it;
            if (r < I_QKV) { p0_transpose_item<0>(w_qkv, DM, NQKV, Wqkv_t, norm_mix, DM - 1, 1.f, scr, r, lane); continue; } r -= I_QKV;
            if (r < I_O) { p0_transpose_item<0>(w_o, DM, DM, Wo_t, subln, VD - 1, 1.f - LAMBDA_INIT, scr, r, lane); continue; } r -= I_O;
            if (r < I_O) { p0_transpose_item<0>(w_f, DM, DM, Wf_t, nullptr, 0, 1.f, scr, r, lane); continue; } r -= I_O;
            if (r < I_GU) { p0_transpose_item<1>(w_gu, DM, NGU, Wgu_t0, norm_ffn, DM - 1, 1.f, scr, r, lane); continue; } r -= I_GU;
            if (r < I_GU) { p0_transpose_item<1>(w_gu + (size_t)DM * NGU, DM, NGU, Wgu_t1, norm_ffn + DM, DM - 1, 1.f, scr, r, lane); continue; } r -= I_GU;
            if (r < I_D) { p0_transpose_item<0>(w_dn, DFF, DM, Wd_t0, nullptr, 0, 1.f, scr, r, lane); continue; } r -= I_D;
            p0_transpose_item<0>(w_dn + (size_t)DFF * DM, DFF, DM, Wd_t1, nullptr, 0, 1.f, scr, r, lane);
        }
        for (int row = gw; row < NTOK; row += NGW) {
            const float* src = row < NTOK_P ? x_p + (size_t)row * DM : x_s + (size_t)(row - NTOK_P) * DM;
            const f32x4* s4 = (const f32x4*)src + lane; v2u* d2 = (v2u*)(XB + (size_t)row * DM) + lane;
            float s = 0.f; f32x4 xv[16];
#pragma unroll
            for (int j = 0; j < 16; ++j) xv[j] = s4[64 * j];
#pragma unroll
            for (int j = 0; j < 16; ++j) { const f32x4 v = xv[j]; s += (v[0] * v[0] + v[1] * v[1]) + (v[2] * v[2] + v[3] * v[3]);
                v2u w; w.x = cvt_pk_bf16(v[0], v[1]); w.y = cvt_pk_bf16(v[2], v[3]); d2[64 * j] = w; }
            s = wave_sum(s);
            if (lane == 0) ss0[row] = ss_fix(s);
        }
        const int gt = gw * 64 + lane, NGT = NGW * 64;
        for (int i = gt; i < SEQ_P * 16; i += NGT) { const int pos = i >> 4, f = i & 15;
            const float inv = powf(500000.f, -(float)(2 * f) / 32.f); const float ang = (float)pos * inv; rcos[i] = cosf(ang); rsin[i] = sinf(ang); }
        for (int i = gt; i < NGRP * 2 * GDIM * GDIM; i += NGT) { const int c = i & 511, j = (i >> 9) & 511, part = (i >> 18) & 1, g = i >> 19;
            const int mm = (j * c) & 511; const float a = (float)mm * (2.f / 512.f);
            const float v = (part ? sinpif(a) : cospif(a)) * 0.044194173824159216f * norm_mix[DM + g * GDIM + c];
            Wc[i] = (bf16)(cvt_pk_bf16(v, 0.f) & 0xffffu); }
        for (int i = gt; i < SEQ_P * SEQ_P / 2; i += NGT) {      const int kk = i & (SEQ_P - 1), n = i >> 12; const int part = kk >> 11, k = kk & (SEQ_P / 2 - 1);
            const int mm = (n * k) & (SEQ_P - 1); const float a = (float)mm * (2.f / SEQ_P);
            const float v = (part ? -sinpif(a) : cospif(a)) * 0.015625f;
            D4096[i] = (bf16)(cvt_pk_bf16(v, 0.f) & 0xffffu); }
        for (int i = gt; i < SEQ_S * SEQ_S / 2; i += NGT) { const int kk = i & (SEQ_S - 1), n = i >> 11; const int part = kk >> 10, k = kk & (SEQ_S / 2 - 1);
            const int mm = (n * k) & (SEQ_S - 1); const float a = (float)mm * (2.f / SEQ_S);
            const float v = (part ? -sinpif(a) : cospif(a)) * 0.022097086912079608f;
            D2048[i] = (bf16)(cvt_pk_bf16(v, 0.f) & 0xffffu); }
      }
        if (BOTH(0)) GRID_BAR();
    }

    if (IN(1)) {
        ProbPlain P{XB, Wqkv_t, DM, DM, DM}; pg8::StaticOrder S; S.init(NTOK / 256, NQKV / 256, G, bx);
        EpiQKV E{QKV, ss0, rcos, rsin, -1, {}, ldsl + ROPE_LDS_OFF};
        pg8::gemm_phase<ProbPlain, EpiQKV, pg8::StaticOrder, PG8_ALIGN, PG8_SP2>(ldsl + RING_OFF, P, S, E);
        if (BOTH(1)) GRID_BAR();
    }

    if (IN(2)) {
        const float s1 = wave_sum(lq1[lane] * lk1[lane] + lq1[lane + 64] * lk1[lane + 64]);
        const float s2 = wave_sum(lq2[lane] * lk2[lane] + lq2[lane + 64] * lk2[lane + 64]);
        const float lam = expf(s1) - expf(s2) + LAMBDA_INIT;
        unsigned* stash = (unsigned*)OB + ((size_t)vcu * 4 + (wave & 3)) * 4096;
        for (int i = 0;; ++i) {
            int idx = i * G + vcu; if (idx >= 4096) break;
            int kv0, q0, seq, h;
            if (idx < 2048) { const int qt = idx & 31, bh = idx >> 5; h = bh & 15; kv0 = (bh >> 4) * SEQ_P; q0 = qt * 128; seq = SEQ_P; }
            else { idx -= 2048; const int qt = idx & 15, bh = idx >> 4; h = bh & 15; kv0 = NTOK_P + (bh >> 4) * SEQ_S; q0 = qt * 128; seq = SEQ_S; }
            attn2::unit(QKV + (size_t)kv0 * NQKV + h * 256, q0, seq, OC + (size_t)(kv0 + q0) * DM + h * 256, lam, stash, (char*)lds + RING_OFF);
        }
        if (IN(2) && hi > 3) GRID_BAR();
    }

    if (IN(4)) {
        ProbPlain P{OC, Wo_t, DM, DM, DM}; pg8::StaticOrder S; S.init(NTOK / 256, DM / 256, G, bx);
        EpiRes E{XB, ss1};
        pg8::gemm_phase<ProbPlain, EpiRes, pg8::StaticOrder, PG8_ALIGN, PG8_SP2>(ldsl + RING_OFF, P, S, E);
        if (BOTH(4)) GRID_BAR();
    }
    if (IN(5)) {
        ProbPlain P{XB, Wgu_t0, DM, DM, DM}; pg8::StaticOrder S; S.init(NTOK / 256, NGU / 256, G, bx);
        EpiGateUp E{HB, ss1, -1, {}};
        pg8::gemm_phase<ProbPlain, EpiGateUp, pg8::StaticOrder, PG8_ALIGN, PG8_SP2>(ldsl + RING_OFF, P, S, E);
        if (BOTH(5)) GRID_BAR();
    }
    if (IN(6)) {
        ProbPlain P{HB, Wd_t0, DFF, DFF, DFF}; pg8::StaticOrder S; S.init(NTOK / 256, DM / 256, G, bx, WGM_DOWN);
        EpiRes E{XB, ss2};
        pg8::gemm_phase<ProbPlain, EpiRes, pg8::StaticOrder, PG8_ALIGN, PG8_SP2>(ldsl + RING_OFF, P, S, E);
        if (BOTH(6)) GRID_BAR();
    }
    if (IN(7)) {
        for (int t = gw; t < 16384; t += NGW) {
            int k, seq; size_t tok0;
            if (t < 8192) { k = t & 2047; seq = SEQ_P; tok0 = (size_t)(t >> 11) * SEQ_P; } else { const int t2 = t - 8192; k = t2 & 1023; seq = SEQ_S; tok0 = NTOK_P + (size_t)(t2 >> 10) * SEQ_S; }
            const size_t r1 = tok0 + k, r2 = tok0 + (k ? seq - k : 0);
            const float rs1 = ss_rstd(ss2[r1]), rs2 = k ? ss_rstd(ss2[r2]) : 0.f;
            const v2u* p1 = (const v2u*)(XB + r1 * DM) + lane; const v2u* p2 = (const v2u*)(XB + r2 * DM) + lane;
            v2u* qe = (v2u*)(XF + r1 * DM) + lane; v2u* qo = (v2u*)(XF + (r1 + seq / 2) * DM) + lane;
            v2u a[16], b[16];
#pragma unroll
            for (int j = 0; j < 16; ++j) { a[j] = p1[64 * j]; b[j] = p2[64 * j]; }
#pragma unroll
            for (int j = 0; j < 16; ++j) {
                const f32x4 x1 = (f32x4){bf_lo(a[j].x), bf_hi(a[j].x), bf_lo(a[j].y), bf_hi(a[j].y)} * rs1, x2 = (f32x4){bf_lo(b[j].x), bf_hi(b[j].x), bf_lo(b[j].y), bf_hi(b[j].y)} * rs2;
                const f32x4 e = x1 + x2; f32x4 o = x1 - x2; if (k == 0) o = (f32x4){0.f, 0.f, 0.f, 0.f};
                v2u we, wo; we.x = cvt_pk_bf16(e[0], e[1]); we.y = cvt_pk_bf16(e[2], e[3]); wo.x = cvt_pk_bf16(o[0], o[1]); wo.y = cvt_pk_bf16(o[2], o[3]);
                qe[64 * j] = we; qo[64 * j] = wo; }
        }
        for (int t = gw; t < 12 * NGRP * 8; t += NGW) {
            const int jc = t & 7, g = (t >> 3) & 7, bi = t >> 6;
            const int seq = bi < NB_P ? SEQ_P : SEQ_S; const size_t row = (bi < NB_P ? (size_t)bi * SEQ_P : NTOK_P + (size_t)(bi - NB_P) * SEQ_S) + seq / 2;
            const float rs = ss_rstd(ss2[row]) * (bi < NB_P ? 0.015625f : 0.022097086912079608f);
            const v4u xw = *((const v4u*)(XB + row * DM + g * GDIM) + lane);
            const f32x4 xa = (f32x4){bf_lo(xw.x), bf_hi(xw.x), bf_lo(xw.y), bf_hi(xw.y)} * rs, xb = (f32x4){bf_lo(xw.z), bf_hi(xw.z), bf_lo(xw.w), bf_hi(xw.w)} * rs;
            const bf16* wrow = Wc + ((size_t)g * 2 * 512 + jc * 64) * GDIM + 8 * lane;
            for (int jj = 0; jj < 64; ++jj) {
                const v4u w = *(const v4u*)(wrow + (size_t)jj * GDIM);
                float d = (bf_lo(w.x) * xa[0] + bf_hi(w.x) * xa[1]) + (bf_lo(w.y) * xa[2] + bf_hi(w.y) * xa[3]) + (bf_lo(w.z) * xb[0] + bf_hi(w.z) * xb[1]) + (bf_lo(w.w) * xb[2] + bf_hi(w.w) * xb[3]);
                d = wave_sum(d);
                if (lane == 0) avec[(size_t)bi * DM + g * GDIM + jc * 64 + jj] = d;
            }
        }
        if (BOTH(7)) GRID_BAR();
    }
    if (IN(8)) {
        { ProbChanDft P{Wc, XF, GDIM, GDIM, DM, SEQ_P, 0}; pg8::StaticOrder S; S.init(NB_P * NGRP * 2, SEQ_P / 256, G, bx);
          EpiBf16Plain E{YT, SEQ_P};
          pg8::gemm_phase<ProbChanDft, EpiBf16Plain, pg8::StaticOrder, PG8_ALIGN, PG8_SP2>(ldsl + RING_OFF, P, S, E); }
        { ProbChanDft P{Wc, XF, GDIM, GDIM, DM, SEQ_S, NTOK_P}; pg8::StaticOrder S; S.init(NB_S * NGRP * 2, SEQ_S / 256, G, bx);
          EpiBf16Plain E{YT + (size_t)NTOK_P * DM, SEQ_S};
          pg8::gemm_phase<ProbChanDft, EpiBf16Plain, pg8::StaticOrder, PG8_ALIGN, PG8_SP2>(ldsl + RING_OFF, P, S, E); }
        if (BOTH(8)) GRID_BAR();
    }
    bf16* Ebuf = (bf16*)(ws + WS_HB);
    if (IN(9)) {
        { ProbSeqDftH P{D4096, YT, SEQ_P / 2, SEQ_P, SEQ_P, SEQ_P / 512, 0}; pg8::StaticOrder S; S.init(NB_P * (SEQ_P / 512), DM / 256, G, bx);
          EpiSeqE E{Ebuf, avec, SEQ_P / 512};
          pg8::gemm_phase<ProbSeqDftH, EpiSeqE, pg8::StaticOrder, PG8_ALIGN, PG8_SP2>(ldsl + RING_OFF, P, S, E); }
        { ProbSeqDftH P{D2048, YT + (size_t)NTOK_P * DM, SEQ_S / 2, SEQ_S, SEQ_S, SEQ_S / 512, 0}; pg8::StaticOrder S; S.init(NB_S * (SEQ_S / 512), DM / 256, G, bx);
          EpiSeqE E{Ebuf + (size_t)(NTOK_P / 2) * DM, avec + (size_t)NB_P * DM, SEQ_S / 512};
          pg8::gemm_phase<ProbSeqDftH, EpiSeqE, pg8::StaticOrder, PG8_ALIGN, PG8_SP2>(ldsl + RING_OFF, P, S, E); }
        for (int r = gw; r < (NB_P + NB_S) * DM; r += NGW) {
            const bool pr = r < NB_P * DM; const int rr = pr ? r : r - NB_P * DM, b = rr >> 12, col = rr & (DM - 1), seq = pr ? SEQ_P : SEQ_S;
            const bf16* y = (pr ? YT : YT + (size_t)NTOK_P * DM) + ((size_t)b * DM + col) * seq;
            float sacc = 0.f;
            for (int k = lane * 8; k < seq / 2; k += 512) { const v4u q = *(const v4u*)(y + k);
                sacc += (bf_lo(q.x) - bf_hi(q.x)) + (bf_lo(q.y) - bf_hi(q.y)) + (bf_lo(q.z) - bf_hi(q.z)) + (bf_lo(q.w) - bf_hi(q.w)); }
            sacc = wave_sum(sacc);
            if (lane == 0) { const float v = sacc * (pr ? 0.015625f : 0.022097086912079608f) + avec[(size_t)(pr ? b : NB_P + b) * DM + col];
                bf16* o = FB + ((pr ? (size_t)b * SEQ_P : (size_t)NTOK_P + (size_t)b * SEQ_S) + seq / 2) * DM + col;
                *(unsigned short*)o = (unsigned short)(cvt_pk_bf16(v, 0.f) & 0xffffu); }
        }
        if (BOTH(9)) GRID_BAR();
    }
    if (IN(10)) {
        { ProbSeqDftH P{D4096, YT, SEQ_P / 2, SEQ_P, SEQ_P, SEQ_P / 512, SEQ_P / 2}; pg8::StaticOrder S; S.init(NB_P * (SEQ_P / 512), DM / 256, G, bx);
          EpiSeqO E{Ebuf, FB, SEQ_P / 512, SEQ_P};
          pg8::gemm_phase<ProbSeqDftH, EpiSeqO, pg8::StaticOrder, PG8_ALIGN, PG8_SP2>(ldsl + RING_OFF, P, S, E); }
        { ProbSeqDftH P{D2048, YT + (size_t)NTOK_P * DM, SEQ_S / 2, SEQ_S, SEQ_S, SEQ_S / 512, SEQ_S / 2}; pg8::StaticOrder S; S.init(NB_S * (SEQ_S / 512), DM / 256, G, bx);
          EpiSeqO E{Ebuf + (size_t)(NTOK_P / 2) * DM, FB + (size_t)NTOK_P * DM, SEQ_S / 512, SEQ_S};
          pg8::gemm_phase<ProbSeqDftH, EpiSeqO, pg8::StaticOrder, PG8_ALIGN, PG8_SP2>(ldsl + RING_OFF, P, S, E); }
        if (BOTH(10)) GRID_BAR();
    }
    if (IN(11)) {
        ProbPlain P{FB, Wf_t, DM, DM, DM}; pg8::StaticOrder S; S.init(NTOK / 256, DM / 256, G, bx);
        EpiRes E{XB, ss3};
        pg8::gemm_phase<ProbPlain, EpiRes, pg8::StaticOrder, PG8_ALIGN, PG8_SP2>(ldsl + RING_OFF, P, S, E);
        if (BOTH(11)) GRID_BAR();
    }
    if (IN(12)) {
        ProbPlain P{XB, Wgu_t1, DM, DM, DM}; pg8::StaticOrder S; S.init(NTOK / 256, NGU / 256, G, bx);
        EpiGateUp E{HB, ss3, -1, {}};
        pg8::gemm_phase<ProbPlain, EpiGateUp, pg8::StaticOrder, PG8_ALIGN, PG8_SP2>(ldsl + RING_OFF, P, S, E);
        if (BOTH(12)) GRID_BAR();
    }
    if (IN(13)) {
        ProbPlain P{HB, Wd_t1, DFF, DFF, DFF}; pg8::StaticOrder S; S.init(NTOK / 256, DM / 256, G, bx, WGM_DOWN);
        EpiRes E{XB, ss4};
        pg8::gemm_phase<ProbPlain, EpiRes, pg8::StaticOrder, PG8_ALIGN, PG8_SP2>(ldsl + RING_OFF, P, S, E);
        if (BOTH(13)) GRID_BAR();
    }
    if (IN(14)) {
        for (int row = gw; row < NTOK; row += NGW) {
            const float rs = ss_rstd(ss4[row]);
            f32x4* o4 = (f32x4*)(out + (size_t)row * DM) + lane; const f32x4* g4 = (const f32x4*)norm_final + lane; const v2u* x2 = (const v2u*)(XB + (size_t)row * DM) + lane;
            v2u xv[16];
#pragma unroll
            for (int j = 0; j < 16; ++j) xv[j] = x2[64 * j];
#pragma unroll
            for (int j = 0; j < 16; ++j) o4[64 * j] = (f32x4){bf_lo(xv[j].x), bf_hi(xv[j].x), bf_lo(xv[j].y), bf_hi(xv[j].y)} * rs * g4[64 * j];
        }
    }
#undef IN
#undef BOTH
#undef GRID_BAR
}

extern "C" void kernel_launch(void* const* d_in, const int* in_sizes, int n_in, void* d_out, int out_size, void* d_ws, size_t ws_size, hipStream_t stream) {
    static int grid = 0;
    if (grid == 0) {
        if (n_in != 15 || in_sizes[0] != NTOK_P * DM || in_sizes[1] != (NTOK - NTOK_P) * DM || out_size != NTOK * DM || ws_size < WS_END) {
            fprintf(stderr, "kernel_launch: shape mismatch (n_in %d, in0 %d, in1 %d, out %d, ws %zu; need ws >= %zu); nothing launched\n", n_in, n_in > 0 ? in_sizes[0] : -1, n_in > 1 ? in_sizes[1] : -1, out_size, ws_size, (size_t)WS_END); grid = -1; return; }
        int dev = 0, cus = 0, per_cu = 0;
        if (hipGetDevice(&dev) != hipSuccess || hipDeviceGetAttribute(&cus, hipDeviceAttributeMultiprocessorCount, dev) != hipSuccess) { fprintf(stderr, "kernel_launch: device query failed\n"); grid = -1; return; }
        if (hipFuncSetAttribute((const void*)fwd_kernel, hipFuncAttributeMaxDynamicSharedMemorySize, LDS_BYTES) != hipSuccess) { fprintf(stderr, "kernel_launch: hipFuncSetAttribute failed\n"); grid = -1; return; }
        if (hipOccupancyMaxActiveBlocksPerMultiprocessor(&per_cu, (const void*)fwd_kernel, NWAVES * 64, LDS_BYTES) != hipSuccess || per_cu < 1)
            fprintf(stderr, "kernel_launch: note: occupancy query reports %d workgroups per CU\n", per_cu);
        (void)hipGetLastError();
        grid = cus;
    }
    if (grid < 0) return;
    if (hipMemsetAsync((char*)d_ws + WS_CTL, 0, CTL_ZERO_BYTES, stream) != hipSuccess) { fprintf(stderr, "kernel_launch: memset failed\n"); return; }
    Args a{};
    for (int i = 0; i < 15; ++i) a.in[i] = (const float*)d_in[i];
    a.out = (float*)d_out; a.ws = (unsigned char*)d_ws;
#if MK_PER_PHASE
    for (int p = 0; p < N_PHASES; ++p) { a.ph_lo = p; a.ph_hi = p + 1; hipLaunchKernelGGL(fwd_kernel, dim3(grid), dim3(NWAVES * 64), LDS_BYTES, stream, a); }
#else
    a.ph_lo = 0; a.ph_hi = N_PHASES;
    hipLaunchKernelGGL(fwd_kernel, dim3(grid), dim3(NWAVES * 64), LDS_BYTES, stream, a);
#endif
    const hipError_t le = hipPeekAtLastError();
    if (le != hipSuccess) fprintf(stderr, "kernel_launch: launch failed: %s\n", hipGetErrorName(le));
}
```
